# Optimizing an MI355X kernel written in HIP

```python
import math
import jax
import jax.numpy as jnp
from jax import lax
import numpy as np

D_MODEL = 1024
BATCH = 32
SEQ = 2048
DEPTH = 1

MIX_WIDTH = D_MODEL
RG_WIDTH = MIX_WIDTH // 2
RG_BLOCKS = 8
RG_BLOCK = RG_WIDTH // RG_BLOCKS
CONV_W = 4
RG_C = 8.0
NSA_WIDTH = MIX_WIDTH - RG_WIDTH
NSA_HEADS = 8
HEAD_DIM = NSA_WIDTH // NSA_HEADS
NSA_KV = 2
NSA_HPG = NSA_HEADS // NSA_KV
KV_W = NSA_KV * HEAD_DIM
CMP_L = 32
CMP_STRIDE = 16
CMP_HIDDEN = 256
SEL_L = 64
N_SEL = 8
WINDOW = 512
Q_BLK = 64
NUM_BUCKETS = 32
MAX_DIST = 128
MEM_LEN = 256
X_HEADS = 4
X_HEAD_DIM = D_MODEL // X_HEADS
N_GROUPS = 4
EXP_PER_GROUP = 8
N_EXPERTS = N_GROUPS * EXP_PER_GROUP
TOP_K_IN_GROUP = 2
D_EXPERT = 512
MOE_BLK = 128
EPS = 1e-6
NEG_INF = -1e30
SEL_FORCE = 1e9
PROJ_SIZES = [RG_WIDTH, RG_WIDTH, NSA_WIDTH, KV_W, KV_W, KV_W, KV_W, KV_W, KV_W, 3 * NSA_HEADS]
PROJ_COLS = sum(PROJ_SIZES)

kernel_name = 'hymba_rglru_nsa_hiermoe_layer'


def rmsnorm(x, g):
    x32 = x.astype(jnp.float32)
    y = x32 * lax.rsqrt(jnp.mean(x32 * x32, axis=-1, keepdims=True) + EPS)
    return (y * g.astype(jnp.float32)).astype(x.dtype)


def masked_softmax(logits, mask):
    return jax.nn.softmax(jnp.where(mask, logits, NEG_INF), axis=-1)


def rel_bucket(dist):
    n = jnp.maximum(dist, 0)
    max_exact = NUM_BUCKETS // 2
    nf = jnp.maximum(n, 1).astype(jnp.float32)
    large = max_exact + (jnp.log(nf / max_exact) / math.log(MAX_DIST / max_exact)
                         * (NUM_BUCKETS - max_exact)).astype(jnp.int32)
    large = jnp.minimum(large, NUM_BUCKETS - 1)
    return jnp.where(n < max_exact, n, large)


def _lru_combine(c1, c2):
    a1, b1 = c1
    a2, b2 = c2
    return a1 * a2, a2 * b1 + b2


def rglru_group(u, gate, conv_w, conv_b, w_r, b_r, w_i, b_i, lam):
    bsz, seq, width = u.shape
    uc = lax.conv_general_dilated(u, conv_w, window_strides=(1,), padding=[(CONV_W - 1, 0)],
                                  dimension_numbers=('NWC', 'WIO', 'NWC'),
                                  feature_group_count=width) + conv_b
    ub = uc.reshape(bsz, seq, RG_BLOCKS, RG_BLOCK)
    r = jax.nn.sigmoid((jnp.einsum('bshi,hij->bshj', ub, w_r).reshape(bsz, seq, width) + b_r).astype(jnp.float32))
    i_g = jax.nn.sigmoid((jnp.einsum('bshi,hij->bshj', ub, w_i).reshape(bsz, seq, width) + b_i).astype(jnp.float32))
    log_a = -RG_C * r * jax.nn.softplus(-lam.astype(jnp.float32))
    a = jnp.exp(log_a)
    b_in = jnp.sqrt(-jnp.expm1(2.0 * log_a)) * i_g * uc.astype(jnp.float32)
    _, h = lax.associative_scan(_lru_combine, (a, b_in), axis=1)
    return (jax.nn.gelu(gate.astype(jnp.float32)) * h).astype(u.dtype)


def nsa_group(q, kc, vc, ks, vs, kw, vw, gate_logits, rel_bias, g_q, g_kc, g_ks, g_kw,
              pos_k, pos_v, ck_w1, ck_w2, cv_w1, cv_w2):
    bsz, seq = q.shape[:2]
    dt = q.dtype
    q = rmsnorm(q, g_q)
    ks = rmsnorm(ks, g_ks)
    kw = rmsnorm(kw, g_kw)
    scale = HEAD_DIM ** -0.5

    n_cmp = (seq - CMP_L) // CMP_STRIDE + 1
    cmp_start = jnp.arange(n_cmp, dtype=jnp.int32) * CMP_STRIDE
    cmp_end = cmp_start + CMP_L - 1
    cmp_center = cmp_start + CMP_L // 2
    gidx = cmp_start[:, None] + jnp.arange(CMP_L, dtype=jnp.int32)[None, :]

    def compress(t, pos, w1, w2):
        blk = t[:, gidx] + pos[None, None, :, None, :]
        blk = blk.transpose(0, 1, 3, 2, 4).reshape(bsz, n_cmp, NSA_KV, CMP_L * HEAD_DIM)
        return jax.nn.gelu(blk @ w1) @ w2

    k_cmp = rmsnorm(compress(kc, pos_k, ck_w1, ck_w2), g_kc)
    v_cmp = compress(vc, pos_v, cv_w1, cv_w2)

    n_sel = seq // SEL_L
    k_sel = min(N_SEL, n_sel)
    sel_start = jnp.arange(n_sel, dtype=jnp.int32) * SEL_L
    overlap = ((cmp_start[:, None] <= sel_start[None, :] + SEL_L - 1) &
               (cmp_end[:, None] >= sel_start[None, :])).astype(jnp.float32)
    ks_blk = ks.reshape(bsz, n_sel, SEL_L, NSA_KV, HEAD_DIM).transpose(0, 3, 1, 2, 4)
    vs_blk = vs.reshape(bsz, n_sel, SEL_L, NSA_KV, HEAD_DIM).transpose(0, 3, 1, 2, 4)
    gather = jax.vmap(jax.vmap(lambda kb, ib: kb[ib]))

    kw_pad = jnp.pad(kw, ((0, 0), (WINDOW, 0), (0, 0), (0, 0)))
    vw_pad = jnp.pad(vw, ((0, 0), (WINDOW, 0), (0, 0), (0, 0)))

    table_g = rel_bias.reshape(NUM_BUCKETS, NSA_KV, NSA_HPG).transpose(1, 0, 2)
    g_arange = jnp.arange(NSA_KV)[None, :, None, None]
    gates = jax.nn.sigmoid(gate_logits.astype(jnp.float32))
    n_blk = seq // Q_BLK
    q_b = q.reshape(bsz, n_blk, Q_BLK, NSA_KV, NSA_HPG, HEAD_DIM).transpose(1, 0, 2, 3, 4, 5)
    g_b = gates.reshape(bsz, n_blk, Q_BLK, NSA_KV, NSA_HPG, 3).transpose(1, 0, 2, 3, 4, 5)

    def block_fn(args):
        i, qb, gb = args
        t = i * Q_BLK + jnp.arange(Q_BLK, dtype=jnp.int32)
        lc = jnp.einsum('bqgpd,bcgd->bgpqc', qb, k_cmp).astype(jnp.float32) * scale
        lc = lc + table_g[:, rel_bucket(t[:, None] - cmp_center[None, :])].transpose(0, 3, 1, 2)[None]
        mc = cmp_end[None, :] <= t[:, None]
        pc = jnp.where(mc, masked_softmax(lc, mc), 0.0)
        o_c = jnp.einsum('bgpqc,bcgd->bqgpd', pc.astype(dt), v_cmp)
        imp = jnp.einsum('bgpqc,cn->bgqn', pc, overlap)
        cur = t // SEL_L
        blk_ids = jnp.arange(n_sel, dtype=jnp.int32)[None, :]
        forced = (blk_ids == 0) | (blk_ids == cur[:, None]) | (blk_ids == cur[:, None] - 1)
        future = blk_ids > cur[:, None]
        imp = jnp.where(forced, SEL_FORCE, jnp.where(future, -SEL_FORCE, imp))
        _, sel = lax.top_k(imp, k_sel)
        k_s = gather(ks_blk, sel).reshape(bsz, NSA_KV, Q_BLK, k_sel * SEL_L, HEAD_DIM)
        v_s = gather(vs_blk, sel).reshape(bsz, NSA_KV, Q_BLK, k_sel * SEL_L, HEAD_DIM)
        kpos = (sel[..., None] * SEL_L + jnp.arange(SEL_L, dtype=jnp.int32)).reshape(bsz, NSA_KV, Q_BLK, k_sel * SEL_L)
        dist = t[None, None, :, None] - kpos
        bs = table_g[g_arange, rel_bucket(dist)].transpose(0, 1, 4, 2, 3)
        ls = jnp.einsum('bqgpd,bgqkd->bgpqk', qb, k_s).astype(jnp.float32) * scale + bs
        ps = masked_softmax(ls, (dist >= 0)[:, :, None])
        o_s = jnp.einsum('bgpqk,bgqkd->bqgpd', ps.astype(dt), v_s)
        k_w = lax.dynamic_slice_in_dim(kw_pad, i * Q_BLK, WINDOW + Q_BLK, axis=1)
        v_w = lax.dynamic_slice_in_dim(vw_pad, i * Q_BLK, WINDOW + Q_BLK, axis=1)
        wpos = i * Q_BLK - WINDOW + jnp.arange(WINDOW + Q_BLK, dtype=jnp.int32)
        dw = t[:, None] - wpos[None, :]
        mw = (dw >= 0) & (dw < WINDOW) & (wpos[None, :] >= 0)
        lw = jnp.einsum('bqgpd,bkgd->bgpqk', qb, k_w).astype(jnp.float32) * scale
        lw = lw + table_g[:, rel_bucket(dw)].transpose(0, 3, 1, 2)[None]
        pw = masked_softmax(lw, mw)
        o_w = jnp.einsum('bgpqk,bkgd->bqgpd', pw.astype(dt), v_w)
        out = gb[..., 0:1] * o_c + gb[..., 1:2] * o_s + gb[..., 2:3] * o_w
        return out.astype(dt)

    o = lax.map(block_fn, (jnp.arange(n_blk, dtype=jnp.int32), q_b, g_b))
    return o.transpose(1, 0, 2, 3, 4, 5).reshape(bsz, seq, NSA_WIDTH)


def memory_cross_attention(h, mem, g_h, g_m, w_q, w_kv, w_o, g_q, g_k):
    bsz, seq, _ = h.shape
    hn = rmsnorm(h, g_h)
    mn = rmsnorm(mem, g_m)
    q = rmsnorm((hn @ w_q).reshape(bsz, seq, X_HEADS, X_HEAD_DIM), g_q)
    k, v = jnp.split(mn @ w_kv, 2, axis=-1)
    k = rmsnorm(k.reshape(bsz, -1, X_HEADS, X_HEAD_DIM), g_k)
    v = v.reshape(bsz, -1, X_HEADS, X_HEAD_DIM)
    logits = jnp.einsum('bshd,bmhd->bhsm', q, k).astype(jnp.float32) * (X_HEAD_DIM ** -0.5)
    p = jax.nn.softmax(logits, axis=-1)
    o = jnp.einsum('bhsm,bmhd->bshd', p.astype(v.dtype), v).reshape(bsz, seq, D_MODEL)
    return o @ w_o


def hierarchical_moe(h, g_norm, w_grp, b_grp, w_exp, b_exp, w1, w3, w2):
    xt = rmsnorm(h, g_norm).reshape(-1, D_MODEL)
    n_tok = xt.shape[0]
    gl = (xt @ w_grp).astype(jnp.float32) + b_grp
    gp = jax.nn.softmax(gl, axis=-1)
    g_sel = jnp.argmax(gl, axis=-1)
    p_g = jnp.take_along_axis(gp, g_sel[:, None], axis=1)[:, 0]
    el = (xt @ w_exp).astype(jnp.float32).reshape(n_tok, N_GROUPS, EXP_PER_GROUP) + b_exp.reshape(N_GROUPS, EXP_PER_GROUP)
    el = jnp.take_along_axis(el, g_sel[:, None, None], axis=1)[:, 0]
    top_p, top_e = lax.top_k(jax.nn.softmax(el, axis=-1), TOP_K_IN_GROUP)
    top_p = top_p / jnp.sum(top_p, axis=-1, keepdims=True)
    weights = (p_g[:, None] * top_p).reshape(-1)
    expert = (g_sel[:, None] * EXP_PER_GROUP + top_e).reshape(-1).astype(jnp.int32)
    token = jnp.repeat(jnp.arange(n_tok, dtype=jnp.int32), TOP_K_IN_GROUP)
    n_slots = n_tok * TOP_K_IN_GROUP
    order = jnp.argsort(expert)
    s_exp, s_tok, s_w = expert[order], token[order], weights[order]
    counts = jnp.bincount(expert, length=N_EXPERTS)
    starts = jnp.cumsum(counts) - counts
    pcounts = (counts + MOE_BLK - 1) // MOE_BLK * MOE_BLK
    pends = jnp.cumsum(pcounts)
    pstarts = pends - pcounts
    dest = pstarts[s_exp] + (jnp.arange(n_slots, dtype=jnp.int32) - starts[s_exp])
    n_blocks = -(-n_slots // MOE_BLK) + N_EXPERTS
    n_pad = n_blocks * MOE_BLK
    buf_tok = jnp.zeros((n_pad,), jnp.int32).at[dest].set(s_tok)
    buf_w = jnp.zeros((n_pad,), jnp.float32).at[dest].set(s_w)
    blk_exp = jnp.minimum(jnp.searchsorted(pends, jnp.arange(n_blocks, dtype=jnp.int32) * MOE_BLK, side='right'),
                          N_EXPERTS - 1)

    def expert_block(args):
        e, tok = args
        xb = xt[tok]
        return (jax.nn.silu(xb @ w1[e]) * (xb @ w3[e])) @ w2[e]

    yb = lax.map(expert_block, (blk_exp, buf_tok.reshape(n_blocks, MOE_BLK))).reshape(n_pad, D_MODEL)
    y = jnp.zeros((n_tok, D_MODEL), jnp.float32).at[buf_tok].add(yb.astype(jnp.float32) * buf_w[:, None])
    return y.reshape(h.shape).astype(h.dtype)


def setup_inputs(seed: int = 0) -> dict:
    key = jax.random.key(seed)
    kit = iter(jax.random.split(key, 64))
    f32 = jnp.float32
    L = DEPTH

    def nrm(shape, scale):
        return jax.random.normal(next(kit), shape, f32) * scale

    def gain(shape):
        return 1.0 + 0.02 * jax.random.normal(next(kit), shape, f32)

    x = nrm((BATCH, SEQ, D_MODEL), 1.0)
    mem = nrm((BATCH, MEM_LEN, D_MODEL), 1.0)
    rel_bias = nrm((NUM_BUCKETS, NSA_HEADS), 0.5)
    norm_mix = gain((L, D_MODEL))
    w_in = nrm((L, D_MODEL, PROJ_COLS), D_MODEL ** -0.5)
    rg_conv_w = nrm((L, CONV_W, 1, RG_WIDTH), CONV_W ** -0.5)
    rg_conv_b = nrm((L, RG_WIDTH), 0.02)
    rg_w_r = nrm((L, RG_BLOCKS, RG_BLOCK, RG_BLOCK), RG_BLOCK ** -0.5)
    rg_b_r = nrm((L, RG_WIDTH), 0.02)
    rg_w_i = nrm((L, RG_BLOCKS, RG_BLOCK, RG_BLOCK), RG_BLOCK ** -0.5)
    rg_b_i = nrm((L, RG_WIDTH), 0.02)
    a0 = jax.random.uniform(next(kit), (L, RG_WIDTH), f32, minval=0.9, maxval=0.999) ** (1.0 / RG_C)
    rg_lambda = jnp.log(a0) - jnp.log1p(-a0)
    nsa_g_q = gain((L, HEAD_DIM))
    nsa_g_kc = gain((L, HEAD_DIM))
    nsa_g_ks = gain((L, HEAD_DIM))
    nsa_g_kw = gain((L, HEAD_DIM))
    cmp_pos_k = nrm((L, CMP_L, HEAD_DIM), 0.02)
    cmp_pos_v = nrm((L, CMP_L, HEAD_DIM), 0.02)
    cmp_k_w1 = nrm((L, CMP_L * HEAD_DIM, CMP_HIDDEN), (CMP_L * HEAD_DIM) ** -0.5)
    cmp_k_w2 = nrm((L, CMP_HIDDEN, HEAD_DIM), CMP_HIDDEN ** -0.5)
    cmp_v_w1 = nrm((L, CMP_L * HEAD_DIM, CMP_HIDDEN), (CMP_L * HEAD_DIM) ** -0.5)
    cmp_v_w2 = nrm((L, CMP_HIDDEN, HEAD_DIM), CMP_HIDDEN ** -0.5)
    out_g_rg = gain((L, RG_WIDTH))
    out_g_nsa = gain((L, NSA_WIDTH))
    w_out = nrm((L, MIX_WIDTH, D_MODEL), MIX_WIDTH ** -0.5)
    norm_x = gain((L, D_MODEL))
    norm_mem = gain((L, D_MODEL))
    xa_w_q = nrm((L, D_MODEL, D_MODEL), D_MODEL ** -0.5)
    xa_w_kv = nrm((L, D_MODEL, 2 * D_MODEL), D_MODEL ** -0.5)
    xa_w_o = nrm((L, D_MODEL, D_MODEL), D_MODEL ** -0.5)
    xa_g_q = gain((L, X_HEAD_DIM))
    xa_g_k = gain((L, X_HEAD_DIM))
    norm_moe = gain((L, D_MODEL))
    router_g_w = nrm((L, D_MODEL, N_GROUPS), D_MODEL ** -0.5)
    router_g_b = nrm((L, N_GROUPS), 0.01)
    router_e_w = nrm((L, D_MODEL, N_EXPERTS), D_MODEL ** -0.5)
    router_e_b = nrm((L, N_EXPERTS), 0.01)
    exp_w1 = nrm((L, N_EXPERTS, D_MODEL, D_EXPERT), D_MODEL ** -0.5)
    exp_w3 = nrm((L, N_EXPERTS, D_MODEL, D_EXPERT), D_MODEL ** -0.5)
    exp_w2 = nrm((L, N_EXPERTS, D_EXPERT, D_MODEL), D_EXPERT ** -0.5)
    return {'x': x, 'mem': mem, 'rel_bias': rel_bias, 'norm_mix': norm_mix, 'w_in': w_in,
            'rg_conv_w': rg_conv_w, 'rg_conv_b': rg_conv_b, 'rg_w_r': rg_w_r, 'rg_b_r': rg_b_r,
            'rg_w_i': rg_w_i, 'rg_b_i': rg_b_i, 'rg_lambda': rg_lambda,
            'nsa_g_q': nsa_g_q, 'nsa_g_kc': nsa_g_kc, 'nsa_g_ks': nsa_g_ks, 'nsa_g_kw': nsa_g_kw,
            'cmp_pos_k': cmp_pos_k, 'cmp_pos_v': cmp_pos_v, 'cmp_k_w1': cmp_k_w1, 'cmp_k_w2': cmp_k_w2,
            'cmp_v_w1': cmp_v_w1, 'cmp_v_w2': cmp_v_w2, 'out_g_rg': out_g_rg, 'out_g_nsa': out_g_nsa,
            'w_out': w_out, 'norm_x': norm_x, 'norm_mem': norm_mem, 'xa_w_q': xa_w_q, 'xa_w_kv': xa_w_kv,
            'xa_w_o': xa_w_o, 'xa_g_q': xa_g_q, 'xa_g_k': xa_g_k, 'norm_moe': norm_moe,
            'router_g_w': router_g_w, 'router_g_b': router_g_b, 'router_e_w': router_e_w,
            'router_e_b': router_e_b, 'exp_w1': exp_w1, 'exp_w3': exp_w3, 'exp_w2': exp_w2}


def reference(x, mem, rel_bias, norm_mix, w_in, rg_conv_w, rg_conv_b, rg_w_r, rg_b_r, rg_w_i, rg_b_i,
              rg_lambda, nsa_g_q, nsa_g_kc, nsa_g_ks, nsa_g_kw, cmp_pos_k, cmp_pos_v, cmp_k_w1, cmp_k_w2,
              cmp_v_w1, cmp_v_w2, out_g_rg, out_g_nsa, w_out, norm_x, norm_mem, xa_w_q, xa_w_kv, xa_w_o,
              xa_g_q, xa_g_k, norm_moe, router_g_w, router_g_b, router_e_w, router_e_b,
              exp_w1, exp_w3, exp_w2):
    bsz, seq, _ = x.shape
    offsets = np.cumsum(PROJ_SIZES)[:-1].tolist()
    h = x
    for l in range(DEPTH):
        proj = rmsnorm(h, norm_mix[l]) @ w_in[l]
        u, gate, q, kc, vc, ks, vs, kw, vw, gl = jnp.split(proj, offsets, axis=-1)
        y_rg = rglru_group(u, gate, rg_conv_w[l], rg_conv_b[l], rg_w_r[l], rg_b_r[l],
                           rg_w_i[l], rg_b_i[l], rg_lambda[l])
        kvs = lambda t: t.reshape(bsz, seq, NSA_KV, HEAD_DIM)
        y_nsa = nsa_group(q.reshape(bsz, seq, NSA_HEADS, HEAD_DIM), kvs(kc), kvs(vc), kvs(ks), kvs(vs),
                          kvs(kw), kvs(vw), gl.reshape(bsz, seq, NSA_HEADS, 3), rel_bias,
                          nsa_g_q[l], nsa_g_kc[l], nsa_g_ks[l], nsa_g_kw[l], cmp_pos_k[l], cmp_pos_v[l],
                          cmp_k_w1[l], cmp_k_w2[l], cmp_v_w1[l], cmp_v_w2[l])
        mixed = jnp.concatenate([rmsnorm(y_rg, out_g_rg[l]), rmsnorm(y_nsa, out_g_nsa[l])], axis=-1)
        h = h + mixed @ w_out[l]
        h = h + memory_cross_attention(h, mem, norm_x[l], norm_mem[l], xa_w_q[l], xa_w_kv[l], xa_w_o[l],
                                       xa_g_q[l], xa_g_k[l])
        h = h + hierarchical_moe(h, norm_moe[l], router_g_w[l], router_g_b[l], router_e_w[l], router_e_b[l],
                                 exp_w1[l], exp_w3[l], exp_w2[l])
    return h
```

```cpp
#include <hip/hip_runtime.h>
#include <hip/hip_cooperative_groups.h>
#include <cstdio>
#include <cstdint>
#include <type_traits>
namespace cg = cooperative_groups;

#define GAS __attribute__((address_space(1)))
#define LAS __attribute__((address_space(3)))
typedef unsigned short bf16;
typedef short bf16x8 __attribute__((ext_vector_type(8)));
typedef short s16x4 __attribute__((ext_vector_type(4)));
typedef float f32x4 __attribute__((ext_vector_type(4)));
typedef float f32x16 __attribute__((ext_vector_type(16)));
typedef unsigned u32x4 __attribute__((ext_vector_type(4)));
typedef unsigned u32x2 __attribute__((ext_vector_type(2)));

constexpr int DM = 1024, NBATCH = 32, SEQ = 2048, T = NBATCH * SEQ;
constexpr int RGW = 512, NSAW = 512, HD = 64, NH = 8, NKV = 2, KVW = 128;
constexpr int NPROJ = 2328, NPROJ_PAD = 2560;
constexpr int NCMP = 127, NCMP_PAD = 128, CMP_HID = 256;
constexpr int MEML = 256, XH = 4, XHD = 256, TM = NBATCH * MEML;
constexpr int NEXP = 32, DEXP = 512;
constexpr float EPS = 1e-6f;
constexpr float LOG2E = 1.4426950408889634f;
constexpr float QSCALE = 0.125f * LOG2E;
constexpr float XQSCALE = 0.0625f * LOG2E;
constexpr int MOE_MAXT = 288;
constexpr int MOE_ROWS = 2 * MOE_MAXT * 256;

__device__ __forceinline__ float bf2f(unsigned v) { return __uint_as_float(v << 16); }
__device__ __forceinline__ unsigned f2bf(float f) { unsigned u = __float_as_uint(f); return (u + 0x7fffu + ((u >> 16) & 1u)) >> 16; }
__device__ __forceinline__ unsigned pk2(float lo, float hi) { unsigned r; asm volatile("v_cvt_pk_bf16_f32 %0, %1, %2" : "=v"(r) : "v"(lo), "v"(hi)); return r; }
__device__ __forceinline__ float fast_exp2(float x) { return __builtin_amdgcn_exp2f(x); }
__device__ __forceinline__ float fast_rcp(float x) { return __builtin_amdgcn_rcpf(x); }
__device__ __forceinline__ float sigmoidf_(float x) { return fast_rcp(1.f + fast_exp2(-x * LOG2E)); }
__device__ __forceinline__ float gelu_tanh(float x) { const float p = __builtin_fmaf(x * x, -2.3022082f * 0.044715f, -2.3022082f); return x * fast_rcp(1.f + fast_exp2(x * p)); }
__device__ __forceinline__ float silu_(float x) { return x * sigmoidf_(x); }
__device__ __forceinline__ float wave_sum(float v) {
#pragma unroll
    for (int o = 1; o < 64; o <<= 1) v += __shfl_xor(v, o);
    return v;
}
template <int CTRL, int ROWMASK = 0xf> __device__ __forceinline__ float dpp_add(float v) { return v + __int_as_float(__builtin_amdgcn_update_dpp(0, __float_as_int(v), CTRL, ROWMASK, 0xf, true)); }
__device__ __forceinline__ float half_sum_dpp(float s) { s = dpp_add<0xB1>(s); s = dpp_add<0x4E>(s); s = dpp_add<0x141>(s); s = dpp_add<0x140>(s); return dpp_add<0x142, 0xA>(s); }
__device__ const unsigned char kBucket[128] = {0, 1, 2, 3, 4, 5, 6, 7, 8, 9, 10, 11, 12, 13, 14, 15, 16, 16, 16, 17, 17, 18, 18, 18, 19, 19, 19, 20, 20, 20, 20, 21, 21, 21, 21, 22, 22, 22, 22, 22, 23, 23, 23, 23, 23, 23, 24, 24, 24, 24, 24, 24, 25, 25, 25, 25, 25, 25, 25, 26, 26, 26, 26, 26, 26, 26, 26, 27, 27, 27, 27, 27, 27, 27, 27, 27, 27, 28, 28, 28, 28, 28, 28, 28, 28, 28, 28, 29, 29, 29, 29, 29, 29, 29, 29, 29, 29, 29, 29, 30, 30, 30, 30, 30, 30, 30, 30, 30, 30, 30, 30, 30, 30, 31, 31, 31, 31, 31, 31, 31, 31, 31, 31, 31, 31, 31, 31, 31};

__device__ __forceinline__ unsigned pk4_fp8(float a, float b, float c, float d) { unsigned w = 0;
    a = __builtin_amdgcn_fmed3f(a, -448.f, 448.f); b = __builtin_amdgcn_fmed3f(b, -448.f, 448.f); c = __builtin_amdgcn_fmed3f(c, -448.f, 448.f); d = __builtin_amdgcn_fmed3f(d, -448.f, 448.f); w = __builtin_amdgcn_cvt_pk_fp8_f32(a, b, w, false); w = __builtin_amdgcn_cvt_pk_fp8_f32(c, d, w, true); return w; }
#ifndef MOE_FP8
#define MOE_FP8 1
#endif
#ifndef XQ_FP8
#define XQ_FP8 1
#endif
#ifndef XO_FP8
#define XO_FP8 1
#endif
#ifndef XKV_FP8
#define XKV_FP8 0
#endif
constexpr float F8_WKV_SCALE = 32.f;
constexpr float F8_WQ_SCALE = 32.f, F8_WO_SCALE = 32.f, F8_XO_SCALE = 16.f;
constexpr float F8_W13_SCALE = MOE_FP8 ? 32.f : 1.f, F8_W2_SCALE = MOE_FP8 ? 16.f : 1.f, F8_H_SCALE = MOE_FP8 ? 8.f : 1.f;

__device__ __forceinline__ void glds16(const void* gsrc, unsigned lds_dst) { unsigned keep;
    asm volatile("s_mov_b32 %0, m0\n\ts_mov_b32 m0, %2\n\ts_nop 0\n\tglobal_load_lds_dwordx4 %1, off\n\ts_mov_b32 m0, %0" : "=&s"(keep) : "v"(gsrc), "s"(lds_dst) : "memory"); }
namespace pg8 {
#define PG8_LAS __attribute__((address_space(3)))
typedef unsigned short bf16_t;
typedef short bf16x8 __attribute__((ext_vector_type(8)));
typedef float f32x4 __attribute__((ext_vector_type(4)));
typedef unsigned u32x4 __attribute__((ext_vector_type(4)));
typedef unsigned u32x2 __attribute__((ext_vector_type(2)));
constexpr int BM = 256, BK = 64, HALF = 128, HTB = HALF * BK * 2  , STAGE_BYTES = 8 * HTB, NXCD = 8, WGM = 8;

__host__ __device__ __forceinline__ int lds_byte(int r, int c) { const int st = (r >> 4) * 2 + (c >> 5), rr = r & 15, cc = c & 31, ob = rr * 64 + cc * 2; return st * 1024 + (ob ^ (((ob >> 9) & 1) << 5)); }
__host__ __device__ __forceinline__ void stage_rc(int b, int& R, int& C) { const int st = b / 1024, sb = b % 1024, swz = sb ^ (((sb >> 9) & 1) << 5); R = (st >> 1) * 16 + swz / 64; C = (st & 1) * 32 + (swz % 64) / 2; }
__host__ __device__ __forceinline__ int perm32(int rho) { const int n = rho >> 4, i = rho & 15; return 8 * (i >> 2) + 4 * n + (i & 3); }

struct Unit { int pm, pn, aux; };
struct Gemm { int K; int lda; int kstepA; };

__device__ __forceinline__ unsigned cvt_pk_bf16(float lo, float hi) { unsigned r; asm volatile("v_cvt_pk_bf16_f32 %0, %1, %2" : "=v"(r) : "v"(lo), "v"(hi)); return r; }

typedef int v8i32 __attribute__((ext_vector_type(8)));
typedef int v4i32 __attribute__((ext_vector_type(4)));
template <class Epi, class Sched, bool ALIGN_EPI = true, bool SP2 = true, bool F8 = false>
__device__ __forceinline__ void gemm_phase(PG8_LAS unsigned char* lds, const Gemm g, const Sched& S, const Epi& E) {
    const int tid = threadIdx.x, wid = __builtin_amdgcn_readfirstlane(tid >> 6), lane = tid & 63, wr = wid >> 2, wc = wid & 3, fr = lane & 15, fq = lane >> 4;
    const int K = g.K, nt = K / BK;
    unsigned voffA[2], voffB[2]; int growA[2];
#pragma unroll
    for (int i = 0; i < 2; ++i) { int R, C; stage_rc(tid * 16 + i * 8192, R, C); const int Rb = Epi::PERM ? ((R & ~31) + perm32(R & 31)) : R;
        voffA[i] = (unsigned)(R * g.lda + C) * 2u; voffB[i] = (unsigned)(Rb * K + C) * 2u; growA[i] = R; if constexpr (Sched::GATHER) voffA[i] = (unsigned)C * 2u; }
    const size_t kstepA = (size_t)g.kstepA * 2, kstepB = (size_t)(BK * 2);
    const size_t hstepA = (size_t)HALF * g.lda * 2, hstepB = (size_t)HALF * K * 2;
    const unsigned ldsw = (unsigned)wid * 1024u;
    const int aoff = lds_byte(wr * 64 + fr, fq * 8), boff = lds_byte(wc * 32 + fr, fq * 8);
#define PG8_SA(b, h) (((b) * 2 + (h)) * HTB)
#define PG8_SB(b, h) ((4 + (b) * 2 + (h)) * HTB)
#define PG8_STAGE(bufoff, gbase, voff) do { _Pragma("unroll") for (int _i = 0; _i < 2; ++_i) \
        __builtin_amdgcn_global_load_lds((const unsigned*)((const char*)(gbase) + (voff)[_i]), (PG8_LAS unsigned*)(lds + (bufoff) + ldsw + _i * 8192), 16, 0, 0); } while (0)
#define PG8_STAGE_G(bufoff, kbyte, go) do { _Pragma("unroll") for (int _i = 0; _i < 2; ++_i) \
        __builtin_amdgcn_global_load_lds((const unsigned*)(cA + (kbyte) + (go)[_i]), (PG8_LAS unsigned*)(lds + (bufoff) + ldsw + _i * 8192), 16, 0, 0); } while (0)
#define PG8_STAGE_A(bufoff, h, plainptr, kbyte, gsel) do { if constexpr (Sched::GATHER) PG8_STAGE_G(bufoff, kbyte, (gsel)[h]); else PG8_STAGE(bufoff, plainptr, voffA); } while (0)
#define PG8_LD1(dst, addr) do { if constexpr (F8) { const v4i32 _lo = *(const PG8_LAS v4i32*)(addr), _hi = *(const PG8_LAS v4i32*)((addr) + 1024); (dst).v = __builtin_shufflevector(_lo, _hi, 0, 1, 2, 3, 4, 5, 6, 7); } \
        else { (dst)[0] = *(const PG8_LAS bf16x8*)(addr); (dst)[1] = *(const PG8_LAS bf16x8*)((addr) + 1024); } } while (0)
#define PG8_LDA(dst, b, h) do { _Pragma("unroll") for (int m = 0; m < 4; ++m) PG8_LD1(dst[m], lds + PG8_SA(b, h) + aoff + m * 2048); } while (0)
#define PG8_LDB(dst, b, h) do { _Pragma("unroll") for (int n = 0; n < 2; ++n) PG8_LD1(dst[n], lds + PG8_SB(b, h) + boff + n * 2048); } while (0)
#define PG8_MMA(ai, bj, At, Bt) do { __builtin_amdgcn_s_setprio(1); \
        if constexpr (F8) { _Pragma("unroll") for (int m = 0; m < 4; ++m) _Pragma("unroll") for (int n = 0; n < 2; ++n) \
            asm volatile("v_mfma_scale_f32_16x16x128_f8f6f4 %0, %1, %2, %0, %3, %3 op_sel_hi:[0,0,0]" : "+v"(acc[ai][bj][m][n]) : "v"(Bt[n].v), "v"(At[m].v), "v"(f8one)); } \
        else { _Pragma("unroll") for (int m = 0; m < 4; ++m) _Pragma("unroll") for (int n = 0; n < 2; ++n) _Pragma("unroll") for (int k = 0; k < 2; ++k) \
            acc[ai][bj][m][n] = __builtin_amdgcn_mfma_f32_16x16x32_bf16(Bt[n][k], At[m][k], acc[ai][bj][m][n], 0, 0, 0); } \
        __builtin_amdgcn_s_setprio(0); } while (0)
#define PG8_WAIT_V(n) asm volatile("s_waitcnt vmcnt(" #n ")" ::: "memory")
#define PG8_WAIT_L(n) asm volatile("s_waitcnt lgkmcnt(" #n ")" ::: "memory")
#define PG8_BAR __builtin_amdgcn_s_barrier()
#define PG8_SCHED __builtin_amdgcn_sched_barrier(0)
    Unit cur, nxt; int ui = 0;
    if (!S.next(0, cur)) return;
    f32x4 acc[2][2][4][2];
#pragma unroll
    for (int a = 0; a < 2; ++a)
#pragma unroll
        for (int b = 0; b < 2; ++b)
#pragma unroll
            for (int m = 0; m < 4; ++m)
#pragma unroll
                for (int n = 0; n < 2; ++n) acc[a][b][m][n] = (f32x4){0.f, 0.f, 0.f, 0.f};
    const unsigned f8one = 0x7f7f7f7fu;
    typedef bf16x8 frag_t[2];
    struct Frag8 { v8i32 v; };
    typename std::conditional<F8, Frag8, frag_t>::type At[4], B0[2], B1[2];
    const char* cA = S.a_base(cur); const char* cB = S.b_base(cur);
    unsigned goff[2][2] = {{0u, 0u}, {0u, 0u}}, gnext[2][2] = {{0u, 0u}, {0u, 0u}};
    if constexpr (Sched::GATHER) {
#pragma unroll
        for (int h = 0; h < 2; ++h)
#pragma unroll
            for (int i = 0; i < 2; ++i) goff[h][i] = S.row_off(cur, h * HALF + growA[i]) + voffA[i]; }
    static_assert(SP2, "only the SP2 loop is kept in this file");
    if constexpr (Epi::MIDK) E.unit_begin(cur, ui, lds, tid);
    PG8_STAGE(PG8_SB(0, 0), cB, voffB); PG8_STAGE(PG8_SB(0, 1), cB + hstepB, voffB); PG8_STAGE_A(PG8_SA(0, 0), 0, cA, 0, goff); PG8_STAGE_A(PG8_SA(0, 1), 1, cA + hstepA, 0, goff);
    if (wr == 1) PG8_BAR;
    PG8_WAIT_V(2); PG8_BAR;
    PG8_STAGE(PG8_SB(1, 0), cB + kstepB, voffB); PG8_STAGE_A(PG8_SA(1, 0), 0, cA + kstepA, kstepA, goff); PG8_STAGE(PG8_SB(1, 1), cB + hstepB + kstepB, voffB);
    PG8_WAIT_V(6); PG8_BAR;
    for (;;) {
        const bool has_next = S.next(ui + 1, nxt);
        const char* nA = has_next ? S.a_base(nxt) : cA; const char* nB = has_next ? S.b_base(nxt) : cB;
        if constexpr (Sched::GATHER) {
#pragma unroll
            for (int h = 0; h < 2; ++h)
#pragma unroll
                for (int i = 0; i < 2; ++i) gnext[h][i] = has_next ? S.row_off(nxt, h * HALF + growA[i]) + voffA[i] : goff[h][i]; }
#pragma unroll 1
        for (int t = 0; t < nt; t += 2) {
            const bool last = (t == nt - 2);
            const char* a1 = cA + (size_t)(t + 1) * kstepA;
            const char* a2 = last ? nA : cA + (size_t)(t + 2) * kstepA; const char* b2 = last ? nB : cB + (size_t)(t + 2) * kstepB;
            const char* a3 = a2 + kstepA; const char* b3 = b2 + kstepB;
            const size_t k1 = (size_t)(t + 1) * kstepA, k2 = last ? 0 : (size_t)(t + 2) * kstepA, k3 = k2 + kstepA;
            unsigned gs[2][2];
#pragma unroll
            for (int h = 0; h < 2; ++h)
#pragma unroll
                for (int i = 0; i < 2; ++i) gs[h][i] = last ? gnext[h][i] : goff[h][i];
            if constexpr (Epi::MIDK) { if (t == nt / 2) E.midk(acc, cur, ui, lds, wr, wc, fr, fq); }
            PG8_LDB(B0, 0, 0); PG8_LDB(B1, 0, 1); PG8_SCHED; PG8_LDA(At, 0, 0); PG8_STAGE_A(PG8_SA(1, 1), 1, a1 + hstepA, k1, goff);
            PG8_WAIT_V(8); PG8_WAIT_L(0); PG8_BAR; PG8_MMA(0, 0, At, B0); PG8_MMA(0, 1, At, B1); PG8_BAR; PG8_SCHED;
            PG8_LDA(At, 0, 1); PG8_STAGE(PG8_SB(0, 0), b2, voffB); PG8_STAGE(PG8_SB(0, 1), b2 + hstepB, voffB); PG8_STAGE_A(PG8_SA(0, 0), 0, a2, k2, gs);
            PG8_WAIT_V(8); PG8_WAIT_L(0); PG8_BAR; PG8_MMA(1, 0, At, B0); PG8_MMA(1, 1, At, B1); PG8_BAR; PG8_SCHED;
            PG8_LDB(B0, 1, 0); PG8_LDB(B1, 1, 1); PG8_SCHED; PG8_LDA(At, 1, 0); PG8_STAGE_A(PG8_SA(0, 1), 1, a2 + hstepA, k2, gs);
            PG8_WAIT_V(8); PG8_WAIT_L(0); PG8_BAR; PG8_MMA(0, 0, At, B0); PG8_MMA(0, 1, At, B1); PG8_BAR; PG8_SCHED;
            PG8_LDA(At, 1, 1); PG8_STAGE(PG8_SB(1, 0), b3, voffB); PG8_STAGE(PG8_SB(1, 1), b3 + hstepB, voffB); PG8_STAGE_A(PG8_SA(1, 0), 0, a3, k3, gs);
            PG8_WAIT_V(8); PG8_WAIT_L(0); PG8_BAR; PG8_MMA(1, 0, At, B0); PG8_MMA(1, 1, At, B1); PG8_BAR; PG8_SCHED;
        }
        if constexpr (F8) asm volatile("s_nop 15\n\ts_nop 7" ::: "memory");
        if constexpr (F8) {
#pragma unroll
            for (int a = 0; a < 2; ++a)
#pragma unroll
                for (int b = 0; b < 2; ++b)
#pragma unroll
                    for (int m = 0; m < 4; ++m)
#pragma unroll
                        for (int n = 0; n < 2; ++n) asm volatile("" : "+v"(acc[a][b][m][n])); }
        if constexpr (ALIGN_EPI) { if (wr == 0) PG8_BAR; }
        if constexpr (Epi::MIDK) E.fin(acc, cur, ui, lds, wr, wc, fr, fq); else E(acc, cur, wr, wc, fr, fq);
        if (!has_next) break;
#pragma unroll
        for (int a = 0; a < 2; ++a)
#pragma unroll
            for (int b = 0; b < 2; ++b)
#pragma unroll
                for (int m = 0; m < 4; ++m)
#pragma unroll
                    for (int n = 0; n < 2; ++n) acc[a][b][m][n] = (f32x4){0.f, 0.f, 0.f, 0.f};
        cur = nxt; cA = nA; cB = nB; ++ui;
        if constexpr (Sched::GATHER) {
#pragma unroll
            for (int h = 0; h < 2; ++h)
#pragma unroll
                for (int i = 0; i < 2; ++i) goff[h][i] = gnext[h][i]; }
        if constexpr (Epi::MIDK) E.unit_begin(cur, ui, lds, tid);
        if constexpr (ALIGN_EPI) { if (wr == 1) PG8_BAR; }
    }
    PG8_WAIT_V(0);
    if constexpr (!ALIGN_EPI) { if (wr == 0) PG8_BAR; }
    PG8_BAR;
#undef PG8_SA
#undef PG8_SB
#undef PG8_STAGE
#undef PG8_STAGE_G
#undef PG8_STAGE_A
#undef PG8_LDA
#undef PG8_LDB
#undef PG8_MMA
#undef PG8_LD1
#undef PG8_WAIT_V
#undef PG8_WAIT_L
#undef PG8_BAR
#undef PG8_SCHED
}
}
constexpr size_t MiB = 1u << 20;
constexpr size_t WS_CTL = 0, CTL_BYTES = 64 * 1024;
constexpr size_t WS_RSX = 1 * MiB;
constexpr size_t WS_BIAS2 = WS_RSX + 256 * 1024;
constexpr size_t WS_CB1P = WS_BIAS2 + 8192;
constexpr size_t WS_MOEINFO = WS_CB1P + 32768;
constexpr size_t WS_GTAB = WS_MOEINFO + 8192;
constexpr size_t WS_AOFF = 1 * MiB + 384 * 1024;
constexpr size_t WS_SSQRG = 14 * MiB, WS_SSQNSA = 16 * MiB;
constexpr size_t WS_RSROW = 35 * MiB;
constexpr size_t WS_SSQH1 = 2 * MiB;
constexpr size_t WS_GATES = 6 * MiB;
constexpr size_t WS_RGSUM = 12 * MiB;
constexpr size_t WS_KCMP = 20 * MiB, WS_VCMP = 21 * MiB;
constexpr size_t WS_WR = 22 * MiB;
constexpr size_t WS_TOKINFO = 23 * MiB;
constexpr size_t WS_TOKMAP = 25 * MiB, WS_WSLOT = 26 * MiB;
constexpr size_t WS_CMPHID = 27 * MiB;
constexpr size_t WS_WIN = 36 * MiB, WS_WOUT = 41 * MiB, WS_WQ = 43 * MiB, WS_WKV = 45 * MiB, WS_WO = 49 * MiB, WS_CW1 = 51 * MiB;
constexpr size_t WS_W13 = 53 * MiB, WS_W2 = 117 * MiB;
constexpr size_t WS_A = 150 * MiB;
constexpr size_t WS_B = 278 * MiB;
constexpr size_t WS_U = WS_B, WS_GATE = WS_B + 64 * MiB, WS_Q = WS_B + 128 * MiB, WS_KV6 = WS_B + 192 * MiB;
constexpr size_t WS_H1 = WS_B, WS_H2 = WS_B + 128 * MiB;
constexpr size_t WS_C = 567 * MiB;
constexpr size_t WS_D = 712 * MiB;
constexpr size_t WS_MNB = WS_D, WS_KVX = WS_D + 16 * MiB;
constexpr size_t WS_H2F8 = WS_D;
constexpr size_t WS_H1F8 = WS_D + 64 * MiB;
constexpr size_t WS_Y = WS_D;
constexpr size_t WS_XK8 = WS_MNB;
constexpr size_t WS_END = WS_D + 288 * MiB;
static_assert(WS_KV6 + 96 * MiB + MiB <= WS_C && WS_C + 144 * MiB <= WS_D && WS_W2 + 32 * MiB <= WS_A && WS_A + 128 * MiB <= WS_B, "ws map");

using pg8::Unit;
struct SchedDense {
    static constexpr bool GATHER = false;
    int nM, nN, nwg, G, c; const char* A; const char* B; size_t tA, tB;
    __device__ __forceinline__ void init(int M, int N, int G_, int c_, const void* A_, size_t lda_bytes, const void* B_, size_t ldb_bytes) {
        nM = M / 256; nN = N / 256; nwg = nM * nN; G = G_; c = c_; A = (const char*)A_; B = (const char*)B_; tA = 256 * lda_bytes; tB = 256 * ldb_bytes; }
    __device__ __forceinline__ bool next(int i, Unit& u) const {
        const long L = (long)i * G + c; if (L >= nwg) return false;
        int wgid = (int)L; { const int q = nwg / 8, r = nwg % 8, xcd = wgid % 8, off = wgid / 8; wgid = (xcd < r ? xcd * (q + 1) : r * (q + 1) + (xcd - r) * q) + off; }
        const int nig = 8 * nN, gid = wgid / nig, fm = gid * 8, gsz = (nM - fm) < 8 ? (nM - fm) : 8;
        u.pm = fm + ((wgid % nig) % gsz); u.pn = (wgid % nig) / gsz; u.aux = 0; return true;
    }
    __device__ __forceinline__ const char* a_base(const Unit& u) const { return A + (size_t)u.pm * tA; }
    __device__ __forceinline__ const char* b_base(const Unit& u) const { return B + (size_t)u.pn * tB; }
};

struct EpiPlain {
    static constexpr bool PERM = true, MIDK = false;
    bf16* O; int ldc; float scale;
    __device__ __forceinline__ void operator()(const f32x4 (&acc)[2][2][4][2], const Unit& u, int wr, int wc, int fr, int fq) const {
        const int row0 = u.pm * 256 + wr * 64 + fr, col0 = u.pn * 256 + wc * 32 + 8 * fq;
#pragma unroll
        for (int ai = 0; ai < 2; ++ai)
#pragma unroll
            for (int m = 0; m < 4; ++m) { bf16* rowp = O + (size_t)(row0 + ai * 128 + m * 16) * ldc + col0;
#pragma unroll
                for (int bj = 0; bj < 2; ++bj) { const f32x4 v0 = acc[ai][bj][m][0] * scale, v1 = acc[ai][bj][m][1] * scale;
                    u32x4 w; w.x = pk2(v0[0], v0[1]); w.y = pk2(v0[2], v0[3]); w.z = pk2(v1[0], v1[1]); w.w = pk2(v1[2], v1[3]);
                    *(u32x4*)(rowp + bj * 128) = w; } }
    }
};

struct EpiInProj {
    static constexpr bool PERM = true, MIDK = false;
    unsigned char* ws;
    __device__ __forceinline__ void operator()(const f32x4 (&acc)[2][2][4][2], const Unit& un, int wr, int wc, int fr, int fq) const {
        const int pn = un.pn; const int row0 = un.pm * 256 + wr * 64 + fr;
        const float* rs_x = (const float*)(ws + WS_RSX);
        if (pn < 4) {
            bf16* dst = (bf16*)(ws + WS_U + (size_t)(pn >> 1) * (64 * MiB)) + (pn & 1) * 256 + wc * 32 + 8 * fq;
#pragma unroll
            for (int ai = 0; ai < 2; ++ai)
#pragma unroll
                for (int m = 0; m < 4; ++m) { const int row = row0 + ai * 128 + m * 16; const float rs = rs_x[row];
#pragma unroll
                    for (int bj = 0; bj < 2; ++bj) { const f32x4 v0 = acc[ai][bj][m][0] * rs, v1 = acc[ai][bj][m][1] * rs;
                        u32x4 w; w.x = pk2(v0[0], v0[1]); w.y = pk2(v0[2], v0[3]); w.z = pk2(v1[0], v1[1]); w.w = pk2(v1[2], v1[3]);
                        *(u32x4*)(dst + (size_t)row * 512 + bj * 128) = w; } }
        } else if (pn < 9) {
            size_t doff; int ld, gi; bool norm;
            if (pn < 6) { const int head = 4 * (pn - 4) + wc; doff = WS_Q + (size_t)head * 128; ld = 512; norm = true; gi = 0; }
            else { const int kind = pn - 6, isV = wc >> 1, g = wc & 1; doff = WS_KV6 + (size_t)(kind * 2 + isV) * ((size_t)T * 256) + g * 128; ld = 128; norm = (!isV && kind > 0); gi = kind; }
            bf16* dst = (bf16*)(ws + doff); const float* gain = (const float*)(ws + WS_GTAB) + gi * 64;
            const bool k8 = (pn >= 7) && (wc < 2);
            unsigned char* dst8 = ws + WS_KV6 + (size_t)((pn - 6) * 2) * ((size_t)T * 256) + (wc & 1) * 64;
            f32x4 gv[2][2];
#pragma unroll
            for (int bj = 0; bj < 2; ++bj)
#pragma unroll
                for (int n = 0; n < 2; ++n) { const f32x4 gl = *(const f32x4*)(gain + 32 * bj + 8 * fq + 4 * n); gv[bj][n] = norm ? gl : (f32x4){1.f, 1.f, 1.f, 1.f}; }
#pragma unroll
            for (int ai = 0; ai < 2; ++ai)
#pragma unroll
                for (int m = 0; m < 4; ++m) { const int row = row0 + ai * 128 + m * 16; const float rs = rs_x[row];
                    f32x4 v[2][2]; float ss = 0.f;
#pragma unroll
                    for (int bj = 0; bj < 2; ++bj)
#pragma unroll
                        for (int n = 0; n < 2; ++n) { v[bj][n] = acc[ai][bj][m][n] * rs; const f32x4 x = v[bj][n]; ss += (x[0] * x[0] + x[1] * x[1]) + (x[2] * x[2] + x[3] * x[3]); }
                    ss += __shfl_xor(ss, 16); ss += __shfl_xor(ss, 32);
                    const float r2 = norm ? __builtin_amdgcn_rsqf(ss * (1.f / 64.f) + EPS) : 1.f;
#pragma unroll
                    for (int bj = 0; bj < 2; ++bj) { const f32x4 v0 = v[bj][0] * gv[bj][0] * r2, v1 = v[bj][1] * gv[bj][1] * r2;
                        if (k8) { u32x2 w8; w8.x = pk4_fp8(v0[0], v0[1], v0[2], v0[3]); w8.y = pk4_fp8(v1[0], v1[1], v1[2], v1[3]);
                            *(u32x2*)((unsigned char*)dst8 + (size_t)row * 128 + 32 * bj + 8 * fq) = w8; }
                        else { u32x4 w; w.x = pk2(v0[0], v0[1]); w.y = pk2(v0[2], v0[3]); w.z = pk2(v1[0], v1[1]); w.w = pk2(v1[2], v1[3]);
                            *(u32x4*)(dst + (size_t)row * ld + 32 * bj + 8 * fq) = w; } } }
        } else {
            if (wc == 0 && fq < 3) { float* gates = (float*)(ws + WS_GATES);
#pragma unroll
                for (int ai = 0; ai < 2; ++ai)
#pragma unroll
                    for (int m = 0; m < 4; ++m) { const int row = row0 + ai * 128 + m * 16; const float rs = rs_x[row];
#pragma unroll
                        for (int n = 0; n < 2; ++n) { const f32x4 x = acc[ai][0][m][n] * rs; f32x4 o; o[0] = sigmoidf_(x[0]); o[1] = sigmoidf_(x[1]); o[2] = sigmoidf_(x[2]); o[3] = sigmoidf_(x[3]);
                            *(f32x4*)(gates + (size_t)row * 24 + 8 * fq + 4 * n) = o; } }
            }
        }
    }
};

struct SchedCmp {
    static constexpr bool GATHER = false;
    int G, c; const char* kc; const char* vc; const char* w1;
    __device__ __forceinline__ bool next(int i, Unit& u) const { const int L = i * G + c; if (L >= 64) return false; u.aux = L >> 4; u.pm = L & 15; u.pn = 0; return true; }
    __device__ __forceinline__ const char* a_base(const Unit& u) const { return ((u.aux >> 1) ? vc : kc) + (u.aux & 1) * 128 + (size_t)u.pm * 256 * 4096; }
    __device__ __forceinline__ const char* b_base(const Unit& u) const { return w1 + (size_t)(u.aux >> 1) * (256 * 2048 * 2); }
};
struct EpiCmp1 {
    static constexpr bool PERM = true, MIDK = false;
    bf16* hid; const float* b1p;
    __device__ __forceinline__ void operator()(const f32x4 (&acc)[2][2][4][2], const Unit& u, int wr, int wc, int fr, int fq) const {
        const int kv = u.aux >> 1; const int row0 = u.pm * 256 + wr * 64 + fr, col0 = wc * 32 + 8 * fq;
        f32x4 bv[2][2];
#pragma unroll
        for (int bj = 0; bj < 2; ++bj)
#pragma unroll
            for (int n = 0; n < 2; ++n) { f32x4 s = {0.f, 0.f, 0.f, 0.f};
                for (int pp = 0; pp < 16; ++pp) s += *(const f32x4*)(b1p + (size_t)pp * 512 + kv * 256 + col0 + bj * 128 + 4 * n);
                bv[bj][n] = s; }
        bf16* O = hid + (size_t)u.aux * (4096 * 256);
#pragma unroll
        for (int ai = 0; ai < 2; ++ai)
#pragma unroll
            for (int m = 0; m < 4; ++m) { bf16* rowp = O + (size_t)(row0 + ai * 128 + m * 16) * 256 + col0;
#pragma unroll
                for (int bj = 0; bj < 2; ++bj) { f32x4 v0 = acc[ai][bj][m][0] + bv[bj][0], v1 = acc[ai][bj][m][1] + bv[bj][1];
#pragma unroll
                    for (int j = 0; j < 4; ++j) { v0[j] = gelu_tanh(v0[j]); v1[j] = gelu_tanh(v1[j]); }
                    u32x4 w; w.x = pk2(v0[0], v0[1]); w.y = pk2(v0[2], v0[3]); w.z = pk2(v1[0], v1[1]); w.w = pk2(v1[2], v1[3]);
                    *(u32x4*)(rowp + bj * 128) = w; } }
    }
};

struct EpiRes {
    static constexpr bool PERM = true, MIDK = false;
    const bf16* R; bf16* O; float* ssq; unsigned char* O8; float ascale;
    __device__ __forceinline__ void operator()(const f32x4 (&acc)[2][2][4][2], const Unit& u, int wr, int wc, int fr, int fq) const {
        const int row0 = u.pm * 256 + wr * 64 + fr, col0 = u.pn * 256 + wc * 32 + 8 * fq;
#pragma unroll
        for (int ai = 0; ai < 2; ++ai)
#pragma unroll
            for (int m = 0; m < 4; ++m) { const int row = row0 + ai * 128 + m * 16; const size_t off = (size_t)row * 1024 + col0; float ss = 0.f;
#pragma unroll
                for (int bj = 0; bj < 2; ++bj) { const u32x4 rv = *(const u32x4*)(R + off + bj * 128); f32x4 v0 = acc[ai][bj][m][0] * ascale, v1 = acc[ai][bj][m][1] * ascale;
                    v0[0] += bf2f(rv.x & 0xffffu); v0[1] += bf2f(rv.x >> 16); v0[2] += bf2f(rv.y & 0xffffu); v0[3] += bf2f(rv.y >> 16);
                    v1[0] += bf2f(rv.z & 0xffffu); v1[1] += bf2f(rv.z >> 16); v1[2] += bf2f(rv.w & 0xffffu); v1[3] += bf2f(rv.w >> 16);
                    ss += (v0[0] * v0[0] + v0[1] * v0[1]) + (v0[2] * v0[2] + v0[3] * v0[3]) + (v1[0] * v1[0] + v1[1] * v1[1]) + (v1[2] * v1[2] + v1[3] * v1[3]);
                    u32x4 w; w.x = pk2(v0[0], v0[1]); w.y = pk2(v0[2], v0[3]); w.z = pk2(v1[0], v1[1]); w.w = pk2(v1[2], v1[3]);
                    *(u32x4*)(O + off + bj * 128) = w;
                    if (O8) { u32x2 w8; w8.x = pk4_fp8(v0[0], v0[1], v0[2], v0[3]); w8.y = pk4_fp8(v1[0], v1[1], v1[2], v1[3]); *(u32x2*)(O8 + off + bj * 128) = w8; } }
                if (ssq) { ss += __shfl_xor(ss, 16); ss += __shfl_xor(ss, 32); if (fq == 0) ssq[(size_t)row * 16 + u.pn * 4 + wc] = ss; } }
    }
};

struct MoeInfo { int nt0, nt1; int pad[2]; int tile_exp[2 * MOE_MAXT]; };
template <bool GATH> struct SchedMoeT {
    static constexpr bool GATHER = GATH;
    int G, c, lo, cnt; const int* tile_exp; const char* A; const char* B; size_t tA, tB; const unsigned* aoff;
    __device__ __forceinline__ bool next(int i, Unit& u) const { const int L = i * G + c; if (L >= cnt * 4) return false; const int rt = lo + (L >> 2); const int e = tile_exp[rt]; u.pm = rt; u.pn = e * 4 + (L & 3); u.aux = 0; return true; }
    __device__ __forceinline__ const char* a_base(const Unit& u) const { return GATH ? A : A + (size_t)u.pm * tA; }
    __device__ __forceinline__ const char* b_base(const Unit& u) const { return B + (size_t)u.pn * tB; }
    __device__ __forceinline__ unsigned row_off(const Unit& u, int r) const { return aoff[u.pm * 256 + r]; }
};
struct EpiMoe1 {
    static constexpr bool PERM = true, MIDK = false;
    unsigned char* H; const float* wslot; const float* rsrow;
    __device__ __forceinline__ void operator()(const f32x4 (&acc)[2][2][4][2], const Unit& u, int wr, int wc, int fr, int fq) const {
        const int row0 = u.pm * 256 + wr * 64 + fr, col0 = (u.pn & 3) * 128 + wc * 32 + 8 * fq;
#pragma unroll
        for (int ai = 0; ai < 2; ++ai)
#pragma unroll
            for (int m = 0; m < 4; ++m) { const int row = row0 + ai * 128 + m * 16; const float w = wslot[row] * F8_H_SCALE, rs = rsrow[row] * (1.f / F8_W13_SCALE);
                f32x4 o[2];
#pragma unroll
                for (int n = 0; n < 2; ++n)
#pragma unroll
                    for (int j = 0; j < 4; ++j) o[n][j] = silu_(acc[ai][0][m][n][j] * rs) * (acc[ai][1][m][n][j] * rs) * w;
                if (MOE_FP8) { u32x2 pw; pw.x = pk4_fp8(o[0][0], o[0][1], o[0][2], o[0][3]); pw.y = pk4_fp8(o[1][0], o[1][1], o[1][2], o[1][3]); *(u32x2*)(H + (size_t)row * 512 + col0) = pw; }
                else { u32x4 pw; pw.x = pk2(o[0][0], o[0][1]); pw.y = pk2(o[0][2], o[0][3]); pw.z = pk2(o[1][0], o[1][1]); pw.w = pk2(o[1][2], o[1][3]); *(u32x4*)((bf16*)H + (size_t)row * 512 + col0) = pw; } }
    }
};
struct EpiY {
    static constexpr bool PERM = true, MIDK = false;
    bf16* Y; float scale;
    __device__ __forceinline__ void operator()(const f32x4 (&acc)[2][2][4][2], const Unit& u, int wr, int wc, int fr, int fq) const {
        const int row0 = u.pm * 256 + wr * 64 + fr, col0 = (u.pn & 3) * 256 + wc * 32 + 8 * fq;
#pragma unroll
        for (int ai = 0; ai < 2; ++ai)
#pragma unroll
            for (int m = 0; m < 4; ++m) { bf16* rowp = Y + (size_t)(row0 + ai * 128 + m * 16) * 1024 + col0;
#pragma unroll
                for (int bj = 0; bj < 2; ++bj) { const f32x4 v0 = acc[ai][bj][m][0] * scale, v1 = acc[ai][bj][m][1] * scale;
                    u32x4 w; w.x = pk2(v0[0], v0[1]); w.y = pk2(v0[2], v0[3]); w.z = pk2(v1[0], v1[1]); w.w = pk2(v1[2], v1[3]);
                    *(u32x4*)(rowp + bj * 128) = w; } }
    }
};
template <int PASS> struct EpiMoe2 {
    static constexpr bool PERM = true, MIDK = false;
    const int* tokmap; const bf16* Rin; bf16* P0; float* out;
    __device__ __forceinline__ void operator()(const f32x4 (&acc)[2][2][4][2], const Unit& u, int wr, int wc, int fr, int fq) const {
        const int row0 = u.pm * 256 + wr * 64 + fr, col0 = (u.pn & 3) * 256 + wc * 32 + 8 * fq;
        int tk[2][4];
#pragma unroll
        for (int ai = 0; ai < 2; ++ai)
#pragma unroll
            for (int m = 0; m < 4; ++m) tk[ai][m] = tokmap[row0 + ai * 128 + m * 16];
#pragma unroll
        for (int ai = 0; ai < 2; ++ai) {
            u32x4 rv[4][2];
#pragma unroll
            for (int m = 0; m < 4; ++m) { const size_t off = (size_t)max(tk[ai][m], 0) * 1024 + col0;
#pragma unroll
                for (int bj = 0; bj < 2; ++bj) rv[m][bj] = *(const u32x4*)(Rin + off + bj * 128); }
#pragma unroll
            for (int m = 0; m < 4; ++m) { const int tok = tk[ai][m]; const size_t off = (size_t)max(tok, 0) * 1024 + col0;
#pragma unroll
                for (int bj = 0; bj < 2; ++bj) { const u32x4 r = rv[m][bj]; f32x4 v0 = acc[ai][bj][m][0] * (1.f / (F8_H_SCALE * F8_W2_SCALE)), v1 = acc[ai][bj][m][1] * (1.f / (F8_H_SCALE * F8_W2_SCALE));
                    v0[0] += bf2f(r.x & 0xffffu); v0[1] += bf2f(r.x >> 16); v0[2] += bf2f(r.y & 0xffffu); v0[3] += bf2f(r.y >> 16);
                    v1[0] += bf2f(r.z & 0xffffu); v1[1] += bf2f(r.z >> 16); v1[2] += bf2f(r.w & 0xffffu); v1[3] += bf2f(r.w >> 16);
                    if (tok >= 0) {
                        if (PASS == 0) { u32x4 w; w.x = pk2(v0[0], v0[1]); w.y = pk2(v0[2], v0[3]); w.z = pk2(v1[0], v1[1]); w.w = pk2(v1[2], v1[3]); *(u32x4*)(P0 + off + bj * 128) = w; }
                        else { *(f32x4*)(out + off + bj * 128) = v0; *(f32x4*)(out + off + bj * 128 + 4) = v1; } } } }
        }
    }
};
typedef float f32x2v __attribute__((ext_vector_type(2)));
struct EpiOutMid {
    static constexpr bool PERM = true, MIDK = true;
    const bf16* R; bf16* O; float* ssq; const float* sq_rg; const float* sq_nsa; unsigned char* O8;
    __device__ __forceinline__ void unit_begin(const Unit& u, int ui, PG8_LAS unsigned char* lds, int tid) const {
        if (tid < 256) { const int row = u.pm * 256 + tid;
            const f32x4 a = *(const f32x4*)(sq_rg + (size_t)row * 8), b = *(const f32x4*)(sq_rg + (size_t)row * 8 + 4), c = *(const f32x4*)(sq_nsa + (size_t)row * 8), d = *(const f32x4*)(sq_nsa + (size_t)row * 8 + 4);
            const float r1 = __builtin_amdgcn_rsqf((((a.x + a.y) + (a.z + a.w)) + ((b.x + b.y) + (b.z + b.w))) * (1.f / 512.f) + EPS);
            const float r2 = __builtin_amdgcn_rsqf((((c.x + c.y) + (c.z + c.w)) + ((d.x + d.y) + (d.z + d.w))) * (1.f / 512.f) + EPS);
            f32x2v o; o.x = r1 / r2; o.y = r2; ((PG8_LAS f32x2v*)(lds + pg8::STAGE_BYTES))[(ui & 1) * 256 + tid] = o; }
    }
    __device__ __forceinline__ void midk(f32x4 (&acc)[2][2][4][2], const Unit& u, int ui, PG8_LAS unsigned char* lds, int wr, int wc, int fr, int fq) const {
        const PG8_LAS f32x2v* tab = (const PG8_LAS f32x2v*)(lds + pg8::STAGE_BYTES) + (ui & 1) * 256 + wr * 64 + fr;
#pragma unroll
        for (int ai = 0; ai < 2; ++ai)
#pragma unroll
            for (int m = 0; m < 4; ++m) { const float f = tab[ai * 128 + m * 16].x;
#pragma unroll
                for (int bj = 0; bj < 2; ++bj)
#pragma unroll
                    for (int n = 0; n < 2; ++n) acc[ai][bj][m][n] *= f; }
    }
    __device__ __forceinline__ void fin(const f32x4 (&acc)[2][2][4][2], const Unit& u, int ui, PG8_LAS unsigned char* lds, int wr, int wc, int fr, int fq) const {
        const PG8_LAS f32x2v* tab = (const PG8_LAS f32x2v*)(lds + pg8::STAGE_BYTES) + (ui & 1) * 256 + wr * 64 + fr;
        const int row0 = u.pm * 256 + wr * 64 + fr, col0 = u.pn * 256 + wc * 32 + 8 * fq;
#pragma unroll
        for (int ai = 0; ai < 2; ++ai) {
            u32x4 rva[4][2];
#pragma unroll
            for (int m = 0; m < 4; ++m)
#pragma unroll
                for (int bj = 0; bj < 2; ++bj) rva[m][bj] = *(const u32x4*)(R + (size_t)(row0 + ai * 128 + m * 16) * 1024 + col0 + bj * 128);
            asm volatile("" : "+v"(rva[0][0]), "+v"(rva[0][1]), "+v"(rva[1][0]), "+v"(rva[1][1]), "+v"(rva[2][0]), "+v"(rva[2][1]), "+v"(rva[3][0]), "+v"(rva[3][1]));
#pragma unroll
            for (int m = 0; m < 4; ++m) { const int row = row0 + ai * 128 + m * 16; const size_t off = (size_t)row * 1024 + col0; float ss = 0.f; const float f = tab[ai * 128 + m * 16].y;
#pragma unroll
                for (int bj = 0; bj < 2; ++bj) { const u32x4 rv = rva[m][bj]; f32x4 v0 = acc[ai][bj][m][0] * f, v1 = acc[ai][bj][m][1] * f;
                    v0[0] += bf2f(rv.x & 0xffffu); v0[1] += bf2f(rv.x >> 16); v0[2] += bf2f(rv.y & 0xffffu); v0[3] += bf2f(rv.y >> 16);
                    v1[0] += bf2f(rv.z & 0xffffu); v1[1] += bf2f(rv.z >> 16); v1[2] += bf2f(rv.w & 0xffffu); v1[3] += bf2f(rv.w >> 16);
                    ss += (v0[0] * v0[0] + v0[1] * v0[1]) + (v0[2] * v0[2] + v0[3] * v0[3]) + (v1[0] * v1[0] + v1[1] * v1[1]) + (v1[2] * v1[2] + v1[3] * v1[3]);
                    u32x4 w; w.x = pk2(v0[0], v0[1]); w.y = pk2(v0[2], v0[3]); w.z = pk2(v1[0], v1[1]); w.w = pk2(v1[2], v1[3]);
                    *(u32x4*)(O + off + bj * 128) = w;
                    if (O8) { u32x2 w8; w8.x = pk4_fp8(v0[0], v0[1], v0[2], v0[3]); w8.y = pk4_fp8(v1[0], v1[1], v1[2], v1[3]); *(u32x2*)(O8 + off + bj * 128) = w8; } }
                ss += __shfl_xor(ss, 16); ss += __shfl_xor(ss, 32); if (fq == 0) ssq[(size_t)row * 16 + u.pn * 4 + wc] = ss; } }
    }
    __device__ __forceinline__ void operator()(const f32x4 (&acc)[2][2][4][2], const Unit& u, int wr, int wc, int fr, int fq) const {}
};
struct Args { const float* in[40]; float* out; unsigned char* ws; int lo, hi; };
typedef const float* fptr_t;
typedef const __attribute__((address_space(4))) fptr_t* intab_t;
struct Ctx {
    intab_t in; float* out; unsigned char* ws; LAS unsigned char* lds; int tid, lane, wave, G, bid;
};

__device__ __forceinline__ void tr_item(const float* W, int ldw, int c0, int cvalid, const float* gain, bf16* WT, int K, int r0, int k0, LAS float* scr, int lane) {
    const int cc = c0 + (lane & 31); const bool ok = cc < cvalid;
    float v[32];
#pragma unroll
    for (int i = 0; i < 32; ++i) { const int kk = 2 * i + (lane >> 5); v[i] = ok ? W[(size_t)(k0 + kk) * ldw + cc] : 0.f; }
    if (gain) { float gq[32];
#pragma unroll
        for (int i = 0; i < 32; ++i) gq[i] = gain[k0 + 2 * i + (lane >> 5)];
#pragma unroll
        for (int i = 0; i < 32; ++i) v[i] *= gq[i]; }
#pragma unroll
    for (int i = 0; i < 32; ++i) { const int kk = 2 * i + (lane >> 5); scr[kk * 33 + (lane & 31)] = v[i]; }
    asm volatile("s_waitcnt lgkmcnt(0)" ::: "memory");
    const int c = lane & 7;
#pragma unroll
    for (int j = 0; j < 4; ++j) { const int n = (lane >> 3) + 8 * j; const LAS float* s = scr + (8 * c) * 33 + n;
        u32x4 o; o.x = pk2(s[0 * 33], s[1 * 33]); o.y = pk2(s[2 * 33], s[3 * 33]); o.z = pk2(s[4 * 33], s[5 * 33]); o.w = pk2(s[6 * 33], s[7 * 33]);
        *(u32x4*)(WT + (size_t)(r0 + n) * K + k0 + 8 * c) = o; }
    asm volatile("s_waitcnt lgkmcnt(0)" ::: "memory");
}
__device__ __forceinline__ void tr_item8(const float* W, int ldw, int c0, const float* gain, float scale, unsigned char* WT8, int K, int r0, int k0, LAS float* scr, int lane) {
    const int cc = c0 + (lane & 31);
    float v[32];
#pragma unroll
    for (int i = 0; i < 32; ++i) { const int kk = 2 * i + (lane >> 5); v[i] = W[(size_t)(k0 + kk) * ldw + cc]; }
    if (gain) { float gq[32];
#pragma unroll
        for (int i = 0; i < 32; ++i) gq[i] = gain[k0 + 2 * i + (lane >> 5)];
#pragma unroll
        for (int i = 0; i < 32; ++i) v[i] *= gq[i]; }
#pragma unroll
    for (int i = 0; i < 32; ++i) { const int kk = 2 * i + (lane >> 5); scr[kk * 33 + (lane & 31)] = v[i] * scale; }
    asm volatile("s_waitcnt lgkmcnt(0)" ::: "memory");
    const int c = lane & 7;
#pragma unroll
    for (int j = 0; j < 4; ++j) { const int n = (lane >> 3) + 8 * j; const LAS float* s = scr + (8 * c) * 33 + n;
        u32x2 o; o.x = pk4_fp8(s[0 * 33], s[1 * 33], s[2 * 33], s[3 * 33]); o.y = pk4_fp8(s[4 * 33], s[5 * 33], s[6 * 33], s[7 * 33]);
        *(u32x2*)(WT8 + (size_t)(r0 + n) * K + k0 + 8 * c) = o; }
    asm volatile("s_waitcnt lgkmcnt(0)" ::: "memory");
}
__device__ __forceinline__ int inproj_src_col(int n0) {
    const int pn = n0 >> 8, cl = n0 & 255, bj = cl >> 7, wc = (cl & 127) >> 5;
    if (pn < 4) return n0;
    if (pn < 6) return 1024 + (4 * (pn - 4) + wc) * 64 + 32 * bj;
    if (pn < 9) { const int base = 1536 + (pn - 6) * 256; return (wc < 2) ? base + wc * 64 + 32 * bj : base + 128 + (wc - 2) * 64 + 32 * bj; }
    return (cl < 32) ? 2304 : 100000;
}
__device__ __forceinline__ void phase_expert_weights(const Ctx& C, int gw, int NGW) {
    LAS float* scr = (LAS float*)(C.lds + C.wave * 16384);
    const intab_t in = C.in; unsigned char* ws = C.ws;
    constexpr int I_13 = 32 * 16, I_2 = 32 * 8;
    for (int it = gw; it < 32 * I_13 + 32 * I_2; it += NGW) {
        int r = it;
        if (r < 32 * I_13) { const int e = r / I_13, rr = r % I_13, nb = rr / 16, kb = rr % 16;
            const int p = nb >> 3, cl = (nb & 7) * 32; const bool is3 = cl >= 128; const int sc = 128 * p + (cl & 127);
            if (MOE_FP8) tr_item8(in[is3 ? 38 : 37] + (size_t)e * 1024 * 512, 512, sc, in[32], F8_W13_SCALE, ws + WS_W13 + (size_t)e * 1024 * 1024, 1024, nb * 32, kb * 64, scr, C.lane);
            else tr_item(in[is3 ? 38 : 37] + (size_t)e * 1024 * 512, 512, sc, 512, in[32], (bf16*)(ws + WS_W13) + (size_t)e * 1024 * 1024, 1024, nb * 32, kb * 64, scr, C.lane);
            continue; } r -= 32 * I_13;
        { const int e = r / I_2, rr = r % I_2, nb = rr / 8, kb = rr % 8;
            if (MOE_FP8) tr_item8(in[39] + (size_t)e * 512 * 1024, 1024, nb * 32, nullptr, F8_W2_SCALE, ws + WS_W2 + (size_t)e * 1024 * 512, 512, nb * 32, kb * 64, scr, C.lane);
            else tr_item(in[39] + (size_t)e * 512 * 1024, 1024, nb * 32, 1024, nullptr, (bf16*)(ws + WS_W2) + (size_t)e * 1024 * 512, 512, nb * 32, kb * 64, scr, C.lane); }
    }
}
struct EwSlab { const float* src; const float* gain; unsigned char* dst; int ld, k0, dstK; float scale; };
__device__ __forceinline__ EwSlab ew_slab(const Ctx& C, int s, int t, int& drow) {
    EwSlab d; const intab_t in = C.in;
    if (s < 1024) { const int e = s >> 5, m = (s >> 4) & 1, kb = s & 15;
        d.src = in[37 + m] + (size_t)e * 1024 * 512 + (size_t)kb * 64 * 512; d.ld = 512; d.gain = in[32]; d.scale = F8_W13_SCALE; d.k0 = kb * 64; d.dstK = 1024;
        d.dst = C.ws + WS_W13 + (size_t)e * 1024 * 1024; drow = 256 * (t >> 7) + 128 * m + (t & 127); }
    else { const int s2 = s - 1024, e = s2 >> 4, kb = (s2 >> 1) & 7, c2 = s2 & 1;
        d.src = in[39] + (size_t)e * 512 * 1024 + (size_t)kb * 64 * 1024 + 512 * c2; d.ld = 1024; d.gain = nullptr; d.scale = F8_W2_SCALE; d.k0 = kb * 64; d.dstK = 512;
        d.dst = C.ws + WS_W2 + (size_t)e * 1024 * 512; drow = 512 * c2 + t; }
    return d; }
__device__ __forceinline__ void phase_expert_weights_wg(const Ctx& C, int wg, int nwg, int s_end = 1536) {
    static_assert(MOE_FP8 != 0, "fp8 expert weights");
    LAS float* tile = (LAS float*)C.lds;
    const int t = C.tid;
    int s = wg; if (s >= s_end) return;
    f32x4 pr[16]; int drow = 0;
    EwSlab cur = ew_slab(C, s, t, drow);
#pragma unroll
    for (int j = 0; j < 16; ++j) { const int q = t + 512 * j; pr[j] = *(const f32x4*)(cur.src + (size_t)(q >> 7) * cur.ld + (q & 127) * 4); }
    for (;;) {
        __syncthreads();
#pragma unroll
        for (int j = 0; j < 16; ++j) *(LAS f32x4*)(tile + (t + 512 * j) * 4) = pr[j];
        const int sn = s + nwg; const bool hn = sn < s_end; int drow_n = 0; EwSlab nx = cur;
        if (hn) { nx = ew_slab(C, sn, t, drow_n);
#pragma unroll
            for (int j = 0; j < 16; ++j) { const int q = t + 512 * j; pr[j] = *(const f32x4*)(nx.src + (size_t)(q >> 7) * nx.ld + (q & 127) * 4); } }
        __syncthreads();
        unsigned char* drp = cur.dst + (size_t)drow * cur.dstK + cur.k0;
#pragma unroll
        for (int g = 0; g < 4; ++g) { float v[16];
#pragma unroll
            for (int k = 0; k < 16; ++k) v[k] = tile[(16 * g + k) * 512 + t] * cur.scale;
            if (cur.gain) { float gq[16];
#pragma unroll
                for (int k = 0; k < 16; ++k) gq[k] = cur.gain[cur.k0 + 16 * g + k];
#pragma unroll
                for (int k = 0; k < 16; ++k) v[k] *= gq[k]; }
            u32x4 o; o.x = pk4_fp8(v[0], v[1], v[2], v[3]); o.y = pk4_fp8(v[4], v[5], v[6], v[7]); o.z = pk4_fp8(v[8], v[9], v[10], v[11]); o.w = pk4_fp8(v[12], v[13], v[14], v[15]);
            *(u32x4*)(drp + 16 * g) = o; }
        if (!hn) break;
        s = sn; cur = nx; drow = drow_n;
    }
    __syncthreads();
}
__device__ __forceinline__ void phase_prologue(const Ctx& C) {
    LAS float* scr = (LAS float*)(C.lds + C.wave * 16384);
    const int gw = C.bid * 8 + C.wave, NGW = C.G * 8;
    const intab_t in = C.in; unsigned char* ws = C.ws;
    constexpr int I_WIN = 80 * 16, I_SQ = 32 * 16, I_KV = 64 * 16, I_CW = 8 * 32;
    constexpr int NIT = I_WIN + 3 * I_SQ + I_KV + 2 * I_CW;
    for (int it = gw; it < NIT; it += NGW) {
        int r = it;
        if (r < I_WIN) { const int nb = r / 16, kb = r % 16; tr_item(in[4], NPROJ, inproj_src_col(nb * 32), NPROJ, in[3], (bf16*)(ws + WS_WIN), 1024, nb * 32, kb * 64, scr, C.lane); continue; } r -= I_WIN;
        if (r < I_SQ) { const int nb = r / 16, kb = r % 16; tr_item(in[24], 1024, nb * 32, 1024, kb < 8 ? in[22] : in[23] - 512, (bf16*)(ws + WS_WOUT), 1024, nb * 32, kb * 64, scr, C.lane); continue; } r -= I_SQ;
        if (r < I_SQ) { const int nb = r / 16, kb = r % 16; if (XQ_FP8) tr_item8(in[27], 1024, nb * 32, in[25], F8_WQ_SCALE, ws + WS_WQ, 1024, nb * 32, kb * 64, scr, C.lane); else tr_item(in[27], 1024, nb * 32, 1024, in[25], (bf16*)(ws + WS_WQ), 1024, nb * 32, kb * 64, scr, C.lane); continue; } r -= I_SQ;
        if (r < I_SQ) { const int nb = r / 16, kb = r % 16; if (XO_FP8) tr_item8(in[29], 1024, nb * 32, nullptr, F8_WO_SCALE, ws + WS_WO, 1024, nb * 32, kb * 64, scr, C.lane); else tr_item(in[29], 1024, nb * 32, 1024, nullptr, (bf16*)(ws + WS_WO), 1024, nb * 32, kb * 64, scr, C.lane); continue; } r -= I_SQ;
        if (r < I_KV) { const int nb = r / 16, kb = r % 16; if (XKV_FP8) tr_item8(in[28], 2048, nb * 32, nullptr, F8_WKV_SCALE, ws + WS_WKV, 1024, nb * 32, kb * 64, scr, C.lane); else tr_item(in[28], 2048, nb * 32, 2048, nullptr, (bf16*)(ws + WS_WKV), 1024, nb * 32, kb * 64, scr, C.lane); continue; } r -= I_KV;
        { const int kv = r / I_CW, rr = r % I_CW, nb = rr / 32, kb = rr % 32; tr_item(in[kv ? 20 : 18], 256, nb * 32, 256, nullptr, (bf16*)(ws + WS_CW1) + (size_t)kv * 256 * 2048, 2048, nb * 32, kb * 64, scr, C.lane); }
    }
    {
        float* rsx = (float*)(ws + WS_RSX); bf16* xb = (bf16*)(ws + WS_A); bf16* mnb = (bf16*)(ws + WS_MNB);
        for (int m0 = 4 * gw; m0 < T + TM; m0 += 4 * NGW) {
            f32x4 v[4][4]; float s[4];
#pragma unroll
            for (int q = 0; q < 4; ++q) { const int m = m0 + q; const float* src = (m < T) ? in[0] + (size_t)m * 1024 : in[1] + (size_t)(m - T) * 1024; const f32x4* xr = (const f32x4*)src + C.lane;
#pragma unroll
                for (int j = 0; j < 4; ++j) v[q][j] = xr[64 * j]; }
#pragma unroll
            for (int q = 0; q < 4; ++q) { float a = 0.f;
#pragma unroll
                for (int j = 0; j < 4; ++j) a += (v[q][j].x * v[q][j].x + v[q][j].y * v[q][j].y) + (v[q][j].z * v[q][j].z + v[q][j].w * v[q][j].w);
                s[q] = a; }
#pragma unroll
            for (int q = 0; q < 4; ++q) { const int m = m0 + q; const bool isx = m < T;
                const float rs = __builtin_amdgcn_rsqf(wave_sum(s[q]) * (1.f / 1024.f) + EPS);
                if (isx) { if (C.lane == 0) rsx[m] = rs;
                    unsigned long long* o8 = (unsigned long long*)(xb + (size_t)m * 1024) + C.lane;
#pragma unroll
                    for (int j = 0; j < 4; ++j) o8[64 * j] = (unsigned long long)pk2(v[q][j].x, v[q][j].y) | ((unsigned long long)pk2(v[q][j].z, v[q][j].w) << 32);
                } else { const f32x4* gr = (const f32x4*)in[26] + C.lane;
                    unsigned long long* o8 = (unsigned long long*)(mnb + (size_t)(m - T) * 1024) + C.lane;
#pragma unroll
                    for (int j = 0; j < 4; ++j) { const f32x4 g = gr[64 * j];
                        if (XKV_FP8) ((unsigned*)((unsigned char*)mnb + (size_t)(m - T) * 1024))[C.lane + 64 * j] = pk4_fp8(v[q][j].x * rs * g.x, v[q][j].y * rs * g.y, v[q][j].z * rs * g.z, v[q][j].w * rs * g.w);
                        else o8[64 * j] = (unsigned long long)pk2(v[q][j].x * rs * g.x, v[q][j].y * rs * g.y) | ((unsigned long long)pk2(v[q][j].z * rs * g.z, v[q][j].w * rs * g.w) << 32); }
                } }
        }
    }
    const int gt = C.bid * 512 + C.tid, NGT = C.G * 512;
    { float* b2 = (float*)(ws + WS_BIAS2);
        for (int i = gt; i < 8 * 132; i += NGT) { const int h = i / 132, d = i % 132; const int bk = d < 128 ? kBucket[d] : 31; b2[i] = in[2][bk * 8 + h] * LOG2E; } }
    { float* bp = (float*)(ws + WS_CB1P);
        if (C.tid < 32) for (int i = C.bid * 32 + C.tid; i < 16 * 512; i += C.G * 32) { const int pp = i / 512, kv = (i % 512) / 256, n = i % 256; const float* pos = in[kv ? 17 : 16]; const float* w1 = in[kv ? 20 : 18];
            float s = 0.f;
#pragma unroll 16
            for (int k = pp * 128; k < pp * 128 + 128; ++k) s += pos[k] * w1[(size_t)k * 256 + n];
            bp[i] = s; } }
    { bf16* wr = (bf16*)(ws + WS_WR);
        for (int i = gt; i < 64 * 1024; i += NGT) { const int n = i / 1024, k = i % 1024; float v = 0.f;
            if (n < 4) v = in[33][k * 4 + n]; else if (n < 36) v = in[35][k * 32 + (n - 4)];
            v *= in[32][k]; const unsigned hi = f2bf(v); const float rem = v - bf2f(hi); wr[i] = (bf16)hi; wr[65536 + i] = (bf16)f2bf(rem); } }
    { float* gt2 = (float*)(ws + WS_GTAB); for (int i = gt; i < 192; i += NGT) { const int k = i / 64, d = i % 64; gt2[i] = (k == 0) ? in[12][d] * QSCALE : (k == 1 ? in[14][d] : in[15][d]); } }
    { int* tm = (int*)(ws + WS_TOKMAP); float* wsl = (float*)(ws + WS_WSLOT);
        unsigned* ao = (unsigned*)(ws + WS_AOFF); float* rr = (float*)(ws + WS_RSROW);
        for (int i = gt; i < MOE_ROWS; i += NGT) { tm[i] = -1; wsl[i] = 0.f; ao[i] = 0u; rr[i] = 0.f; } }
}

__device__ __forceinline__ void pass_knorm(const Ctx& C) {
    bf16* kvx = (bf16*)(C.ws + WS_KVX); const float* gk = C.in[31];
    const int gw = C.bid * 8 + C.wave, NGW = C.G * 8;
    for (int it = gw; it < TM * 4; it += NGW) { const int row = it >> 2, hd = it & 3;
        unsigned long long* p = (unsigned long long*)(kvx + (size_t)row * 2048 + hd * 256) + C.lane;
        const unsigned long long w = *p; const float a = bf2f((unsigned)w & 0xffffu), b = bf2f(((unsigned)w) >> 16), c = bf2f((unsigned)(w >> 32) & 0xffffu), d = bf2f((unsigned)(w >> 48));
        const float rs = __builtin_amdgcn_rsqf(wave_sum(a * a + b * b + c * c + d * d) * (1.f / 256.f) + EPS);
        const f32x4 g = *((const f32x4*)gk + C.lane) * *((const f32x4*)C.in[30] + C.lane);
        ((unsigned*)(C.ws + WS_XK8 + (size_t)row * 1024 + hd * 256))[C.lane] = pk4_fp8(a * rs * g.x, b * rs * g.y, c * rs * g.z, d * rs * g.w);
    }
}
__device__ __forceinline__ void pass_nsanorm(const Ctx& C) {
    bf16* mixed = (bf16*)(C.ws + WS_C);
    const int gw = C.bid * 8 + C.wave, NGW = C.G * 8;
    for (int row = gw; row < T; row += NGW) {
        u32x4* p = (u32x4*)(mixed + (size_t)row * 1024 + 512) + C.lane;
        const u32x4 w = *p; float v[8]; v[0] = bf2f(w.x & 0xffffu); v[1] = bf2f(w.x >> 16); v[2] = bf2f(w.y & 0xffffu); v[3] = bf2f(w.y >> 16); v[4] = bf2f(w.z & 0xffffu); v[5] = bf2f(w.z >> 16); v[6] = bf2f(w.w & 0xffffu); v[7] = bf2f(w.w >> 16);
        float s = 0.f;
#pragma unroll
        for (int j = 0; j < 8; ++j) s += v[j] * v[j];
        const float rs = __builtin_amdgcn_rsqf(wave_sum(s) * (1.f / 512.f) + EPS);
        u32x4 o; o.x = pk2(v[0] * rs, v[1] * rs); o.y = pk2(v[2] * rs, v[3] * rs); o.z = pk2(v[4] * rs, v[5] * rs); o.w = pk2(v[6] * rs, v[7] * rs);
        *p = o;
    }
}
__device__ __forceinline__ int crow(int r, int hi) { return (r & 3) + 8 * (r >> 2) + 4 * hi; }
#define CROW0(r) (((r) & 3) + 8 * ((r) >> 2))
constexpr int RG_CK = 32, RG_NCK = SEQ / RG_CK;
template <bool FINAL> __device__ __forceinline__ void phase_rg(const Ctx& C, int rA = -2, int rB = -1) {
    int lane_ = C.lane; asm volatile("" : "+v"(lane_));
    const int w = C.wave, lane = lane_, r32 = lane & 31, hh = lane >> 5, ch0 = 64 * w;
    const intab_t in = C.in;
    const bf16* U = (const bf16*)(C.ws + WS_U); const bf16* GT = (const bf16*)(C.ws + WS_GATE); bf16* mixed = (bf16*)(C.ws + WS_C);
    float* rgsum = (float*)(C.ws + WS_RGSUM);
    LAS unsigned char* Ub = C.lds + w * 19456; LAS unsigned char* UC = Ub + 10240; LAS unsigned char* Gt = UC + 4608;
    const unsigned ulds = (unsigned)(unsigned long)Ub;
    bf16x8 Br[4][2], Bi[4][2];
    { const float* wr = in[7] + w * 4096; const float* wi = in[9] + w * 4096;
#pragma unroll
        for (int s = 0; s < 4; ++s)
#pragma unroll
            for (int nb = 0; nb < 2; ++nb) { float a[8], b[8];
#pragma unroll
                for (int j = 0; j < 8; ++j) { const int k = 16 * s + 8 * hh + j; a[j] = -LOG2E * wr[k * 64 + 32 * nb + r32]; b[j] = -LOG2E * wi[k * 64 + 32 * nb + r32]; }
                u32x4 pa, pb; pa.x = pk2(a[0], a[1]); pa.y = pk2(a[2], a[3]); pa.z = pk2(a[4], a[5]); pa.w = pk2(a[6], a[7]); pb.x = pk2(b[0], b[1]); pb.y = pk2(b[2], b[3]); pb.z = pk2(b[4], b[5]); pb.w = pk2(b[6], b[7]);
                Br[s][nb] = __builtin_bit_cast(bf16x8, pa); Bi[s][nb] = __builtin_bit_cast(bf16x8, pb); }
    }
    float cbr[2], cbi[2], csp[2];
#pragma unroll
    for (int nb = 0; nb < 2; ++nb) { const int c = ch0 + 32 * nb + r32; cbr[nb] = -LOG2E * in[8][c]; cbi[nb] = -LOG2E * in[10][c]; csp[nb] = -8.f * LOG2E * log1pf(__expf(-in[11][c])); }
    const int ch8 = ch0 + (lane & 7) * 8;
#ifndef RG_REP
#define RG_REP 1
#endif
    constexpr int RUN = 8, NRUN = RG_NCK / RUN;
    for (int rep = 0; rep < RG_REP; ++rep)
    for (int rq = 0; rq < ((rA != -2) ? 2 : (NBATCH * NRUN - C.bid + C.G - 1) / C.G); ++rq) {
      const int rv = (rA != -2) ? (rq ? rB : rA) : C.bid + rq * C.G; if (rv < 0) continue;
      const int b = rv / NRUN, run = rv % NRUN;
      float h0[2] = {0.f, 0.f}, arun[2] = {1.f, 1.f};
      if (FINAL) {
          const char* spu = (const char*)((const float2*)rgsum + ((size_t)b * NRUN) * 512); unsigned spo = (unsigned)(ch0 + r32) * 8u; asm volatile("" : "+v"(spo)); float2 v[NRUN - 1][2];
#pragma unroll
          for (int u = 0; u < NRUN - 1; ++u) if (u < run) { v[u][0] = *(const float2*)(spu + (size_t)u * 4096 + spo); v[u][1] = *(const float2*)(spu + (size_t)u * 4096 + spo + 256); }
#pragma unroll
          for (int u = 0; u < NRUN - 1; ++u) if (u < run) { h0[0] = v[u][0].x * h0[0] + v[u][0].y; h0[1] = v[u][1].x * h0[1] + v[u][1].y; }
      }
      const char* ubu = (const char*)(U + ((size_t)b * SEQ + (size_t)run * RUN * RG_CK) * 512); int uof = ((lane >> 3) - 3) * 1024 + ch8 * 2; asm volatile("" : "+v"(uof));
#define RG_DMA(c, buf) do { _Pragma("unroll") for (int p = 0; p < 5; ++p) glds16(ubu + (size_t)(c) * (RG_CK * 1024) + p * 8192 + (long)uof, (unsigned)__builtin_amdgcn_readfirstlane(ulds + (buf) * 5120 + p * 1024)); } while (0)
      RG_DMA(0, 0);
      for (int cr = 0; cr < RUN; ++cr) {
        const int ck = run * RUN + cr; const size_t t0 = (size_t)b * SEQ + (size_t)ck * RG_CK;
        LAS unsigned char* Ut = Ub + (cr & 1) * 5120;
        asm volatile("s_waitcnt vmcnt(0)" ::: "memory");
        if (cr + 1 < RUN) RG_DMA(cr + 1, (cr + 1) & 1);
        if (ck == 0 && lane < 24) *(LAS u32x4*)(Ut + lane * 16) = (u32x4){0u, 0u, 0u, 0u};
        if (FINAL) {
#pragma unroll
            for (int p = 0; p < 4; ++p) { const int row = p * 8 + (lane >> 3); *(LAS u32x4*)(Gt + row * 144 + (lane & 7) * 16) = *(const u32x4*)(GT + (t0 + row) * 512 + ch8); } }
        { float cw[4][8], cb[8];
#pragma unroll
            for (int j = 0; j < 4; ++j) { const f32x4 a = *(const f32x4*)(in[5] + j * 512 + ch8), b2 = *(const f32x4*)(in[5] + j * 512 + ch8 + 4); cw[j][0] = a.x; cw[j][1] = a.y; cw[j][2] = a.z; cw[j][3] = a.w; cw[j][4] = b2.x; cw[j][5] = b2.y; cw[j][6] = b2.z; cw[j][7] = b2.w; }
            { const f32x4 a = *(const f32x4*)(in[6] + ch8), b2 = *(const f32x4*)(in[6] + ch8 + 4); cb[0] = a.x; cb[1] = a.y; cb[2] = a.z; cb[3] = a.w; cb[4] = b2.x; cb[5] = b2.y; cb[6] = b2.z; cb[7] = b2.w; }
#pragma unroll
            for (int p = 0; p < 4; ++p) { const int row = p * 8 + (lane >> 3); float o[8];
#pragma unroll
                for (int c = 0; c < 8; ++c) o[c] = cb[c];
#pragma unroll
                for (int j = 0; j < 4; ++j) { const u32x4 x = *(const LAS u32x4*)(Ut + (row + j) * 128 + (lane & 7) * 16);
                    o[0] += cw[j][0] * bf2f(x.x & 0xffffu); o[1] += cw[j][1] * bf2f(x.x >> 16); o[2] += cw[j][2] * bf2f(x.y & 0xffffu); o[3] += cw[j][3] * bf2f(x.y >> 16);
                    o[4] += cw[j][4] * bf2f(x.z & 0xffffu); o[5] += cw[j][5] * bf2f(x.z >> 16); o[6] += cw[j][6] * bf2f(x.w & 0xffffu); o[7] += cw[j][7] * bf2f(x.w >> 16); }
                u32x4 pw; pw.x = pk2(o[0], o[1]); pw.y = pk2(o[2], o[3]); pw.z = pk2(o[4], o[5]); pw.w = pk2(o[6], o[7]);
                *(LAS u32x4*)(UC + row * 144 + (lane & 7) * 16) = pw; } }
        f32x16 ar[2], ai[2];
#pragma unroll
        for (int nb = 0; nb < 2; ++nb)
            { float c0 = cbr[nb], c1 = cbi[nb]; asm volatile("" : "+v"(c0), "+v"(c1));
#pragma unroll
            for (int r = 0; r < 16; ++r) { ar[nb][r] = c0; ai[nb][r] = c1; } }
#pragma unroll
        for (int s = 0; s < 4; ++s) { const bf16x8 a = *(const LAS bf16x8*)(UC + r32 * 144 + (16 * s + 8 * hh) * 2);
#pragma unroll
            for (int nb = 0; nb < 2; ++nb) { ar[nb] = __builtin_amdgcn_mfma_f32_32x32x16_bf16(a, Br[s][nb], ar[nb], 0, 0, 0); ai[nb] = __builtin_amdgcn_mfma_f32_32x32x16_bf16(a, Bi[s][nb], ai[nb], 0, 0, 0); } }
#pragma unroll
        for (int nb = 0; nb < 2; ++nb)
#pragma unroll
            for (int r = 0; r < 16; ++r) {
                const float ucv = bf2f((unsigned)*(const LAS unsigned short*)(UC + hh * 576 + r32 * 2 + CROW0(r) * 144 + 64 * nb));
                const float rg = fast_rcp(1.f + fast_exp2(ar[nb][r])), ig = fast_rcp(1.f + fast_exp2(ai[nb][r]));
                const float a = fast_exp2(csp[nb] * rg); const float g2 = __builtin_amdgcn_sqrtf(__builtin_fmaf(-a, a, 1.f));
                ar[nb][r] = a; ai[nb][r] = g2 * ig * ucv; }
#pragma unroll
        for (int nb = 0; nb < 2; ++nb) {
            float SA[4], SB[4], PA[4], PB[4], inown[4];
#pragma unroll
            for (int k = 0; k < 4; ++k) { const float a0 = ar[nb][4 * k], a1 = ar[nb][4 * k + 1], a2 = ar[nb][4 * k + 2], a3 = ar[nb][4 * k + 3];
                SA[k] = (a0 * a1) * (a2 * a3); SB[k] = ((ai[nb][4 * k] * a1 + ai[nb][4 * k + 1]) * a2 + ai[nb][4 * k + 2]) * a3 + ai[nb][4 * k + 3];
                const u32x2 xa = __builtin_amdgcn_permlane32_swap(__float_as_uint(SA[k]), __float_as_uint(SA[k]), false, false), xb = __builtin_amdgcn_permlane32_swap(__float_as_uint(SB[k]), __float_as_uint(SB[k]), false, false);
                SA[k] = __uint_as_float(xa[0]); PA[k] = __uint_as_float(xa[1]); SB[k] = __uint_as_float(xb[0]); PB[k] = __uint_as_float(xb[1]); }
            float st = h0[nb], atot = 1.f;
#pragma unroll
            for (int k = 0; k < 4; ++k) { const float A0 = SA[k], B0 = SB[k], A1 = PA[k], B1 = PB[k];
                const float in0 = st; st = A0 * st + B0; const float in1 = st; st = A1 * st + B1; inown[k] = hh ? in1 : in0; atot *= A0 * A1; }
            if (!FINAL) { arun[nb] *= atot; h0[nb] = st; }
            else { h0[nb] = st;
#pragma unroll
                for (int k = 0; k < 4; ++k) { float h = inown[k];
#pragma unroll
                    for (int j = 0; j < 4; ++j) { h = ar[nb][4 * k + j] * h + ai[nb][4 * k + j]; ai[nb][4 * k + j] = h; } }
            }
        }
        if (FINAL) {
            float ss[16];
#pragma unroll
            for (int r = 0; r < 16; ++r) { float s = 0.f;
#pragma unroll
                for (int nb = 0; nb < 2; ++nb) { const float gv = bf2f((unsigned)*(const LAS unsigned short*)(Gt + hh * 576 + r32 * 2 + CROW0(r) * 144 + 64 * nb)); const float y = gelu_tanh(gv) * ai[nb][r]; ai[nb][r] = y; s += y * y; }
                ss[r] = half_sum_dpp(s); }
            { float* sq = (float*)(C.ws + WS_SSQRG) + (t0 + 4 * hh) * 8 + w;
#pragma unroll
              for (int r = 0; r < 16; ++r) if (r32 == 31) sq[CROW0(r) * 8] = ss[r]; }
#pragma unroll
            for (int r = 0; r < 16; ++r)
#pragma unroll
                for (int nb = 0; nb < 2; ++nb) *(LAS unsigned short*)(Gt + hh * 576 + r32 * 2 + CROW0(r) * 144 + 64 * nb) = (unsigned short)pk2(ai[nb][r], ai[nb][r]);
#pragma unroll
            for (int p = 0; p < 4; ++p) { const int row = p * 8 + (lane >> 3); *(u32x4*)(mixed + (t0 + row) * 1024 + ch8) = *(const LAS u32x4*)(Gt + row * 144 + (lane & 7) * 16); }
        }
      }
#undef RG_DMA
      if (!FINAL) { if (hh == 0) {
#pragma unroll
          for (int nb = 0; nb < 2; ++nb) *(float2*)(rgsum + (((size_t)(b * NRUN + run)) * 512 + ch0 + 32 * nb + r32) * 2) = make_float2(arun[nb], h0[nb]); } }
    }
}

__device__ __forceinline__ void phase_cmp2(const Ctx& C) {
    int lane_ = C.lane; asm volatile("" : "+v"(lane_));
    const int lane = lane_, r32 = lane & 31, hh = lane >> 5; const intab_t in = C.in;
    const bf16* hid = (const bf16*)(C.ws + WS_CMPHID);
    const int gw = C.bid * 8 + C.wave, NGW = C.G * 8;
    for (int task = gw; task < 512; task += NGW) {
        const int set = task >> 7, blk = task & 127, kv = set >> 1, g = set & 1; const float* w2 = in[kv ? 21 : 19];
        const bf16* arow = hid + ((size_t)set * 4096 + blk * 32 + r32) * 256;
        f32x16 acc[2] = {f32x16{}, f32x16{}};
#pragma unroll 4
        for (int s = 0; s < 16; ++s) { const bf16x8 a = *(const bf16x8*)(arow + 16 * s + 8 * hh);
#pragma unroll
            for (int nb = 0; nb < 2; ++nb) { float bv[8];
#pragma unroll
                for (int j = 0; j < 8; ++j) bv[j] = w2[(16 * s + 8 * hh + j) * 64 + 32 * nb + r32];
                u32x4 pb; pb.x = pk2(bv[0], bv[1]); pb.y = pk2(bv[2], bv[3]); pb.z = pk2(bv[4], bv[5]); pb.w = pk2(bv[6], bv[7]);
                acc[nb] = __builtin_amdgcn_mfma_f32_32x32x16_bf16(a, __builtin_bit_cast(bf16x8, pb), acc[nb], 0, 0, 0); } }
        bf16* dst = (bf16*)(C.ws + (kv ? WS_VCMP : WS_KCMP));
        const float g0 = kv ? 1.f : in[13][r32], g1 = kv ? 1.f : in[13][32 + r32];
#pragma unroll
        for (int r = 0; r < 16; ++r) { const int mrow = blk * 32 + 4 * hh + CROW0(r); const int bb = mrow >> 7, c = mrow & 127;
            float v0 = acc[0][r], v1 = acc[1][r];
            if (!kv) { float s = v0 * v0 + v1 * v1; s += __shfl_xor(s, 1); s += __shfl_xor(s, 2); s += __shfl_xor(s, 4); s += __shfl_xor(s, 8); s += __shfl_xor(s, 16);
                const float rs = __builtin_amdgcn_rsqf(s * (1.f / 64.f) + EPS); v0 *= rs * g0; v1 *= rs * g1; }
            if (c == 127) { v0 = 0.f; v1 = 0.f; }
            bf16* o = dst + (((size_t)bb * 128 + c) * 2 + g) * 64;
            o[r32] = (bf16)f2bf(v0); o[32 + r32] = (bf16)f2bf(v1); }
    }
}
typedef short v4i16_t __attribute__((ext_vector_type(4)));
__device__ __forceinline__ s16x4 trread(const LAS unsigned char* p) { return __builtin_bit_cast(s16x4, __builtin_amdgcn_ds_read_tr16_b64_v4i16((LAS v4i16_t*)p)); }
__device__ __forceinline__ bf16x8 cat8(s16x4 a, s16x4 b) { return (bf16x8){a[0], a[1], a[2], a[3], b[0], b[1], b[2], b[3]}; }
__device__ __forceinline__ bf16x8 packp(const f32x16& p, int s2) { u32x4 w; w.x = pk2(p[8 * s2], p[8 * s2 + 1]); w.y = pk2(p[8 * s2 + 2], p[8 * s2 + 3]); w.z = pk2(p[8 * s2 + 4], p[8 * s2 + 5]); w.w = pk2(p[8 * s2 + 6], p[8 * s2 + 7]); return __builtin_bit_cast(bf16x8, w); }
constexpr int NSA_RK = 0, NSA_RV = 24576;
constexpr int NSA_CK = 0, NSA_CV = 16384, NSA_BIAS = 49152, NSA_WSF = 51264, NSA_IMP = 53312, NSA_YS = 87104, NSA_YSTRIDE = 68, NSA_LSUM = 156736;
#define PIN16(b) asm volatile("" : "+v"(b[0]), "+v"(b[1]), "+v"(b[2]), "+v"(b[3]), "+v"(b[4]), "+v"(b[5]), "+v"(b[6]), "+v"(b[7]), "+v"(b[8]), "+v"(b[9]), "+v"(b[10]), "+v"(b[11]), "+v"(b[12]), "+v"(b[13]), "+v"(b[14]), "+v"(b[15]))
__device__ __forceinline__ void y_accum(LAS float* ys, const f32x16 (&o)[2], float f, LAS float* wsf, int r32, int hh, bool accumulate) {
    if (hh == 0) wsf[r32] = f;
    asm volatile("s_waitcnt lgkmcnt(0)" ::: "memory");
    LAS float* yb = ys + 4 * hh * NSA_YSTRIDE + r32;
#pragma unroll
    for (int r = 0; r < 16; ++r) { const float fr = (wsf + 4 * hh)[CROW0(r)];
        if (accumulate) { yb[CROW0(r) * NSA_YSTRIDE] += o[0][r] * fr; yb[CROW0(r) * NSA_YSTRIDE + 32] += o[1][r] * fr; } else { yb[CROW0(r) * NSA_YSTRIDE] = o[0][r] * fr; yb[CROW0(r) * NSA_YSTRIDE + 32] = o[1][r] * fr; } }
    asm volatile("s_waitcnt lgkmcnt(0)" ::: "memory");
}
typedef int v8i32a __attribute__((ext_vector_type(8)));
typedef int v4i32a __attribute__((ext_vector_type(4)));
__device__ __forceinline__ void nsa_tile(const LAS unsigned char* Kt, const LAS unsigned char* Vt, const v8i32a qf8, f32x16 (&o)[2], float& l,
                                         const LAS float* biasp, int jrel, int qq, bool selbit, bool edge, int kbase, int hh, int vbase) {
    f32x16 p[2];
    const bool far = (jrel >= 3) && !edge;
#define NSA_KF(BLK) __builtin_shufflevector(*(const LAS v4i32a*)(Kt + kbase + (BLK) * 512), *(const LAS v4i32a*)(Kt + kbase + 1024 + (BLK) * 512), 0, 1, 2, 3, 4, 5, 6, 7)
    const float cinit = (far && !selbit) ? -1e30f : 0.f;
#pragma unroll
    for (int r = 0; r < 16; ++r) { p[0][r] = cinit; p[1][r] = cinit; }
    p[0] = __builtin_amdgcn_mfma_scale_f32_32x32x64_f8f6f4(NSA_KF(0), qf8, p[0], 0, 0, 0, 0x7f7f7f7f, 0, 0x7f7f7f7f);
    p[1] = __builtin_amdgcn_mfma_scale_f32_32x32x64_f8f6f4(NSA_KF(1), qf8, p[1], 0, 0, 0, 0x7f7f7f7f, 0, 0x7f7f7f7f);
    float ls = 0.f;
    const int dbase = 64 * jrel + qq - 4 * hh;
#pragma unroll
    for (int blk = 0; blk < 2; ++blk) {
        if (far) {
#pragma unroll
            for (int r = 0; r < 16; ++r) p[blk][r] = fast_exp2(p[blk][r]);
        } else if (!edge) { float bb[16];
#pragma unroll
            for (int r = 0; r < 16; ++r) bb[r] = biasp[min(max(dbase - CROW0(r) - 32 * blk, 0), 128)];
            PIN16(bb);
#pragma unroll
            for (int r = 0; r < 16; ++r) { const int d = dbase - CROW0(r) - 32 * blk; const float e = fast_exp2(p[blk][r] + bb[r]); p[blk][r] = (selbit && d >= 0) ? e : 0.f; }
        } else {
#pragma unroll
            for (int r = 0; r < 16; ++r) { const int d = dbase - CROW0(r) - 32 * blk; const float e = fast_exp2(p[blk][r]); p[blk][r] = (d < 512) ? e : 0.f; }
        }
#pragma unroll
        for (int r = 0; r < 16; ++r) ls += p[blk][r];
#pragma unroll
        for (int s2 = 0; s2 < 2; ++s2) { const bf16x8 pf = packp(p[blk], s2);
#pragma unroll
            for (int db = 0; db < 2; ++db) { const LAS unsigned char* vp = Vt + vbase + db * 4096 + (2 * blk + s2) * 1024;
                o[db] = __builtin_amdgcn_mfma_f32_32x32x16_bf16(pf, cat8(trread(vp), trread(vp + 512)), o[db], 0, 0, 0); } }
    }
    l += ls;
#undef NSA_KF
}

__device__ __forceinline__ void nsa_unit(const Ctx& C, int b, int g, int i) {
    int tid = C.tid; asm volatile("" : "+v"(tid));
    const int w = C.wave, lane = tid & 63, r32 = lane & 31, hh = lane >> 5, p = w >> 1, half = w & 1, h = 4 * g + p;
    const int qq = 32 * half + r32, tq = 64 * i + qq;
    LAS unsigned char* lds = C.lds; LAS float* BIAS = (LAS float*)(lds + NSA_BIAS); LAS float* wsf = (LAS float*)(lds + NSA_WSF) + w * 64; LAS float* IMP = (LAS float*)(lds + NSA_IMP); LAS float* LSUM = (LAS float*)(lds + NSA_LSUM);
    const int vbase = ((lane >> 4) & 1) * 32 + (lane & 3) * 8 + (4 * hh + ((lane & 15) >> 2)) * 64;
    const int kbase = hh * 1024 + r32 * 16;
    const int kbase8 = hh * 2048 + r32 * 16;
    const bf16* kv6 = (const bf16*)(C.ws + WS_KV6);
    __syncthreads();
    { const float* b2 = (const float*)(C.ws + WS_BIAS2); for (int idx = tid; idx < 4 * 132; idx += 512) { const int hp = 4 * g + idx / 132; BIAS[idx] = b2[hp * 132 + idx % 132] - b2[hp * 132 + 128]; } }
    { const char* kcu = (const char*)((const bf16*)(C.ws + WS_KCMP) + ((size_t)b * 256 + g) * 64); const char* vcu = (const char*)((const bf16*)(C.ws + WS_VCMP) + ((size_t)b * 256 + g) * 64);
#pragma unroll 1
        for (int pc = 0; pc < 2; ++pc) { const int piece = tid + 512 * pc, row = piece >> 3, ch = piece & 7; const unsigned off = (unsigned)(row * 128 + ch * 8) * 2u; const int tl = row >> 6, rr = row & 63;
            *(LAS u32x4*)(lds + NSA_CK + tl * 8192 + ch * 1024 + rr * 16) = *(const u32x4*)(kcu + off);
            *(LAS u32x4*)(lds + NSA_CV + tl * 8192 + ((ch >> 2) * 4 + (rr >> 4)) * 1024 + (rr & 15) * 64 + (ch & 3) * 16) = *(const u32x4*)(vcu + off); } }
    const size_t tw = (size_t)b * SEQ + 64 * i + 32 * half;
    const float* gpu = (const float*)(C.ws + WS_GATES) + tw * 24 + h * 3; const unsigned gpo = (unsigned)r32 * 24u;
    __syncthreads();
    bf16x8 qf[4];
    { const char* qpu = (const char*)((const bf16*)(C.ws + WS_Q) + tw * 512 + h * 64); const unsigned qo = (unsigned)(r32 * 512 + 8 * hh) * 2u;
#pragma unroll
        for (int s = 0; s < 4; ++s) qf[s] = *(const bf16x8*)(qpu + qo + 32 * s); }
    const LAS float* biasp = BIAS + p * 132;
    LAS float* ys = (LAS float*)(lds + NSA_YS) + w * (32 * NSA_YSTRIDE);
    {
        const int nkb = (4 * i + 3 + 31) >> 5;
        float ls = 0.f, xprev = 0.f; f32x16 oc[2] = {f32x16{}, f32x16{}};
#pragma unroll 1
        for (int kb = 0; kb < nkb; ++kb) {
            f32x16 s0 = f32x16{}; float bb[16];
#pragma unroll
            for (int s = 0; s < 4; ++s) { const LAS unsigned char* kp = lds + NSA_CK + (kb >> 1) * 8192 + kbase + s * 2048 + (kb & 1) * 512;
                s0 = __builtin_amdgcn_mfma_f32_32x32x16_bf16(*(const LAS bf16x8*)kp, qf[s], s0, 0, 0, 0); }
#pragma unroll
            for (int r = 0; r < 16; ++r) { const int c0 = (32 * kb + 4 * hh) + CROW0(r); bb[r] = biasp[min(max(tq - (16 * c0 + 16), 0), 128)]; }
            PIN16(bb);
#pragma unroll
            for (int r = 0; r < 16; ++r) { const int c0 = (32 * kb + 4 * hh) + CROW0(r);
                const float e = fast_exp2(s0[r] + bb[r]); s0[r] = (16 * c0 + 31 <= tq) ? e : 0.f; ls += s0[r]; }
#pragma unroll
            for (int k = 0; k < 4; ++k) { const float a = (s0[4 * k] + s0[4 * k + 1]) + (s0[4 * k + 2] + s0[4 * k + 3]); const float x = __shfl_xor(s0[4 * k + 3], 32);
                IMP[(p * 64 + qq) * 33 + 8 * kb + 2 * k + hh] = a + (hh ? x : xprev); xprev = x; }
#pragma unroll
            for (int s2 = 0; s2 < 2; ++s2) { const bf16x8 pf = packp(s0, s2);
#pragma unroll
                for (int db = 0; db < 2; ++db) { const LAS unsigned char* vp = lds + NSA_CV + (kb >> 1) * 8192 + vbase + db * 4096 + (2 * (kb & 1) + s2) * 1024;
                    oc[db] = __builtin_amdgcn_mfma_f32_32x32x16_bf16(pf, cat8(trread(vp), trread(vp + 512)), oc[db], 0, 0, 0); } }
        }
        ls += __shfl_xor(ls, 32);
        const float inv = ls > 0.f ? fast_rcp(ls) : 0.f;
        if (hh == 0) LSUM[p * 64 + qq] = inv;
        y_accum(ys, oc, gpu[gpo] * inv, wsf, r32, hh, false);
    }
    __syncthreads();
    unsigned selmask;
    if (i <= 7) selmask = (2u << i) - 1u;
    else {
        const float il0 = LSUM[qq], il1 = LSUM[64 + qq], il2 = LSUM[128 + qq], il3 = LSUM[192 + qq];
        float v[29];
#pragma unroll
        for (int n = 1; n <= 29; ++n) { float s = -1.f; if (n <= i - 2) { const LAS float* ip = IMP + qq * 33 + n; s = (ip[0] * il0 + ip[64 * 33] * il1) + (ip[2 * 64 * 33] * il2 + ip[3 * 64 * 33] * il3); } v[n - 1] = s; }
        selmask = 1u | (1u << (i - 1)) | (1u << i);
#pragma unroll
        for (int round = 0; round < 5; ++round) { float best = -1.f; int bi = 0;
#pragma unroll
            for (int n = 1; n <= 29; ++n) if (v[n - 1] > best) { best = v[n - 1]; bi = n; }
            selmask |= 1u << bi;
#pragma unroll
            for (int n = 1; n <= 29; ++n) if (n == bi) v[n - 1] = -2.f; }
    }
    v8i32a qf8;
    { const char* qpu = (const char*)((const bf16*)(C.ws + WS_Q) + tw * 512 + h * 64); const unsigned qo = (unsigned)(r32 * 512 + 32 * hh) * 2u;
#pragma unroll
        for (int s = 0; s < 4; ++s) { const bf16x8 v = *(const bf16x8*)(qpu + qo + 16 * s);
            qf8[2 * s] = (int)pk4_fp8(bf2f((unsigned)(unsigned short)v[0]), bf2f((unsigned)(unsigned short)v[1]), bf2f((unsigned)(unsigned short)v[2]), bf2f((unsigned)(unsigned short)v[3]));
            qf8[2 * s + 1] = (int)pk4_fp8(bf2f((unsigned)(unsigned short)v[4]), bf2f((unsigned)(unsigned short)v[5]), bf2f((unsigned)(unsigned short)v[6]), bf2f((unsigned)(unsigned short)v[7])); } }
    int slot = 0;
    const unsigned lds0 = (unsigned)(unsigned long)lds;
#define NSA_SLOTK(s) ((s) < 3 ? NSA_RK + (s) * 8192 : NSA_IMP + ((s) - 3) * 16384)
#define NSA_SLOTV(s) ((s) < 3 ? NSA_RV + (s) * 8192 : NSA_IMP + ((s) - 3) * 16384 + 8192)
#define NSA_DMA(KG, VG, j) do { const int _s = slot; slot = (slot == 4) ? 0 : slot + 1; \
        if (w < 4) glds16((KG) + (size_t)(j) * 8192 + (unsigned)(lane * 128 + w * 16), (unsigned)__builtin_amdgcn_readfirstlane(lds0 + NSA_SLOTK(_s) + w * 1024)); \
        glds16((VG) + (size_t)(j) * 16384 + (unsigned)((16 * (w & 3) + (lane >> 2)) * 256 + (w >> 2) * 64 + (lane & 3) * 16), (unsigned)__builtin_amdgcn_readfirstlane(lds0 + NSA_SLOTV(_s) + w * 1024)); } while (0)
    __syncthreads();
#ifndef NSA_STREAM_REP
#define NSA_STREAM_REP 1
#endif
#ifndef NSA_VAR
#define NSA_VAR 0
#endif
#pragma unroll 1
    for (int brr = 0; brr < 2 * NSA_STREAM_REP; ++brr) { const int br = 1 + (brr & 1);
        const char* Kgu = (const char*)(kv6 + (size_t)(2 * br) * ((size_t)T * 128)) + ((size_t)b * SEQ) * 128 + g * 64;
        const char* Vgu = (const char*)(kv6 + (size_t)(2 * br + 1) * ((size_t)T * 128) + ((size_t)b * SEQ) * 128 + g * 64);
        const int j0 = (br == 1) ? 0 : (i > 8 ? i - 8 : 0), j1 = i;
        float l = 0.f; f32x16 o[2] = {f32x16{}, f32x16{}};
        int rs_ = slot;
#pragma unroll
        for (int pj = 0; pj < 4; ++pj) if (j0 + pj <= j1 && !(NSA_VAR == 8 && brr >= 2)) NSA_DMA(Kgu, Vgu, j0 + pj);
        for (int j = j0; j <= j1; ++j) {
            const int ahead = j1 - j;
            if (w < 4) { if (ahead >= 3) asm volatile("s_waitcnt vmcnt(6) lgkmcnt(0)\n\ts_barrier" ::: "memory"); else if (ahead == 2) asm volatile("s_waitcnt vmcnt(4) lgkmcnt(0)\n\ts_barrier" ::: "memory");
                else if (ahead == 1) asm volatile("s_waitcnt vmcnt(2) lgkmcnt(0)\n\ts_barrier" ::: "memory"); else asm volatile("s_waitcnt vmcnt(0) lgkmcnt(0)\n\ts_barrier" ::: "memory"); }
            else { if (ahead >= 3) asm volatile("s_waitcnt vmcnt(3) lgkmcnt(0)\n\ts_barrier" ::: "memory"); else if (ahead == 2) asm volatile("s_waitcnt vmcnt(2) lgkmcnt(0)\n\ts_barrier" ::: "memory");
                else if (ahead == 1) asm volatile("s_waitcnt vmcnt(1) lgkmcnt(0)\n\ts_barrier" ::: "memory"); else asm volatile("s_waitcnt vmcnt(0) lgkmcnt(0)\n\ts_barrier" ::: "memory"); }
            if (j + 4 <= j1 && !(NSA_VAR == 8 && brr >= 2)) NSA_DMA(Kgu, Vgu, j + 4);
            const LAS unsigned char* Kt = lds + NSA_SLOTK(rs_); const LAS unsigned char* Vt = lds + NSA_SLOTV(rs_); rs_ = (rs_ == 4) ? 0 : rs_ + 1;
            nsa_tile(Kt, Vt, qf8, o, l, biasp, i - j, qq, (br == 2) || ((selmask >> j) & 1u), (br == 2) && (i - j == 8), kbase8, hh, vbase);
        }
        l += __shfl_xor(l, 32);
        if (brr < 2) y_accum(ys, o, gpu[gpo + br] * fast_rcp(l), wsf, r32, hh, true);
    }
#undef NSA_DMA
#undef NSA_SLOTK
#undef NSA_SLOTV
    { char* mxu = (char*)((bf16*)(C.ws + WS_C) + tw * 1024 + 512 + h * 64);
#pragma unroll 1
        for (int it = 0; it < 4; ++it) { const int row = (lane >> 3) + 8 * it; const LAS float* yr = ys + row * NSA_YSTRIDE + (lane & 7) * 8; const f32x4 a = *(const LAS f32x4*)yr, c = *(const LAS f32x4*)(yr + 4);
            u32x4 pw; pw.x = pk2(a.x, a.y); pw.y = pk2(a.z, a.w); pw.z = pk2(c.x, c.y); pw.w = pk2(c.z, c.w);
            *(u32x4*)(mxu + (size_t)row * 2048 + (lane & 7) * 16) = pw;
            float sq = ((a.x * a.x + a.y * a.y) + (a.z * a.z + a.w * a.w)) + ((c.x * c.x + c.y * c.y) + (c.z * c.z + c.w * c.w)); sq += __shfl_xor(sq, 1); sq += __shfl_xor(sq, 2); sq += __shfl_xor(sq, 4);
            if ((lane & 7) == 0) ((float*)(C.ws + WS_SSQNSA))[(tw + row) * 8 + h] = sq; } }
}
__device__ __forceinline__ void phase_nsa(const Ctx& C) {
    const int vcu = (C.G % 8 == 0) ? (C.bid % 8) * (C.G / 8) + C.bid / 8 : C.bid;
#pragma unroll 1
    for (int v = vcu; v < 256; v += C.G) { const int bg = v >> 2, s = v & 3;
#pragma unroll 1
        for (int ui = 0; ui < 8; ++ui) { const int i = (ui & 1) ? (8 * (ui >> 1) + 7 - s) : (8 * (ui >> 1) + s); nsa_unit(C, bg >> 1, bg & 1, i); } }
}

constexpr int XA_KS8 = 272, XA_VS = 320, XA_KT = 0, XA_KTB = 64 * XA_KS8, XA_VT = 4 * XA_KTB, XA_VTB = 20480, XA_WSF = XA_VT + 40960, XA_OST = XA_WSF + 2048;
__device__ __forceinline__ void xattn_unit(const Ctx& C, int b, int hd, int qb) {
    const int tid = C.tid, w = C.wave, lane = C.lane, r32 = lane & 31, hh = lane >> 5;
    LAS unsigned char* lds = C.lds; LAS float* wsf = (LAS float*)(lds + XA_WSF) + w * 64;
    const size_t tw = (size_t)b * SEQ + 256 * qb + 32 * w;
    bf16* xq = (bf16*)(C.ws + WS_A); const bf16* kvx = (const bf16*)(C.ws + WS_KVX) + (size_t)b * 256 * 2048 + hd * 256;
    const int srow = tid >> 4, sch = tid & 15;
    u32x4 kr[4][2];
    { const char* kgu = (const char*)(C.ws + WS_XK8) + ((size_t)b * 256) * 1024 + hd * 256; const unsigned ko = (unsigned)(srow * 1024 + sch * 16);
#pragma unroll
        for (int kt = 0; kt < 4; ++kt)
#pragma unroll
            for (int pc = 0; pc < 2; ++pc) kr[kt][pc] = *(const u32x4*)(kgu + ko + (size_t)(64 * kt + 32 * pc) * 1024); }
    v8i32a qf8[4];
    { const char* qpu = (const char*)(xq + tw * 1024 + hd * 256); const unsigned qo = (unsigned)(r32 * 1024 + 32 * hh) * 2u; float ss = 0.f; bf16x8 qv[4][4];
#pragma unroll
        for (int s = 0; s < 4; ++s)
#pragma unroll
            for (int i = 0; i < 4; ++i) { qv[s][i] = *(const bf16x8*)(qpu + qo + 128 * s + 16 * i);
#pragma unroll
                for (int j = 0; j < 8; ++j) { const float x = bf2f((unsigned)(unsigned short)qv[s][i][j]); ss += x * x; } }
        ss += __shfl_xor(ss, 32);
        const float* sq = (const float*)(C.ws + WS_SSQH1) + tw * 16 + r32 * 16; float tot = 0.f;
#pragma unroll
        for (int j = 0; j < 4; ++j) { const f32x4 x = *(const f32x4*)(sq + 4 * j); tot += (x.x + x.y) + (x.z + x.w); }
        const float rs = __builtin_amdgcn_rsqf(tot * (1.f / 1024.f) + EPS);
        const float rn = rs * __builtin_amdgcn_rsqf(rs * rs * ss * (1.f / 256.f) + EPS) * XQSCALE;
#pragma unroll
        for (int s = 0; s < 4; ++s)
#pragma unroll
            for (int i = 0; i < 4; ++i) { const bf16x8 v = qv[s][i];
                qf8[s][2 * i] = (int)pk4_fp8(bf2f((unsigned)(unsigned short)v[0]) * rn, bf2f((unsigned)(unsigned short)v[1]) * rn, bf2f((unsigned)(unsigned short)v[2]) * rn, bf2f((unsigned)(unsigned short)v[3]) * rn);
                qf8[s][2 * i + 1] = (int)pk4_fp8(bf2f((unsigned)(unsigned short)v[4]) * rn, bf2f((unsigned)(unsigned short)v[5]) * rn, bf2f((unsigned)(unsigned short)v[6]) * rn, bf2f((unsigned)(unsigned short)v[7]) * rn); } }
    f32x16 sc[4][2];
    __syncthreads();
#pragma unroll
    for (int kt = 0; kt < 4; ++kt)
#pragma unroll
        for (int pc = 0; pc < 2; ++pc) *(LAS u32x4*)(lds + XA_KT + kt * XA_KTB + (srow + 32 * pc) * XA_KS8 + sch * 16) = kr[kt][pc];
    const int vrow = tid >> 4, vch = tid & 15;
    const char* vgu = (const char*)(kvx + 1024); const unsigned vo = (unsigned)(vrow * 2048 + vch * 8) * 2u;
    u32x4 vr[2][2];
#pragma unroll
    for (int t2 = 0; t2 < 2; ++t2)
#pragma unroll
        for (int pc = 0; pc < 2; ++pc) vr[t2][pc] = *(const u32x4*)(vgu + vo + (size_t)(64 * t2 + 32 * pc) * 4096);
    __syncthreads();
#pragma unroll
    for (int kt = 0; kt < 4; ++kt) {
        sc[kt][0] = f32x16{}; sc[kt][1] = f32x16{};
#pragma unroll
        for (int s = 0; s < 4; ++s) { const LAS unsigned char* kp = lds + XA_KT + kt * XA_KTB + r32 * XA_KS8 + 64 * s + 32 * hh;
            const v8i32a a0 = __builtin_shufflevector(*(const LAS v4i32a*)kp, *(const LAS v4i32a*)(kp + 16), 0, 1, 2, 3, 4, 5, 6, 7);
            const v8i32a a1 = __builtin_shufflevector(*(const LAS v4i32a*)(kp + 32 * XA_KS8), *(const LAS v4i32a*)(kp + 32 * XA_KS8 + 16), 0, 1, 2, 3, 4, 5, 6, 7);
            sc[kt][0] = __builtin_amdgcn_mfma_scale_f32_32x32x64_f8f6f4(a0, qf8[s], sc[kt][0], 0, 0, 0, 0x7f7f7f7f, 0, 0x7f7f7f7f);
            sc[kt][1] = __builtin_amdgcn_mfma_scale_f32_32x32x64_f8f6f4(a1, qf8[s], sc[kt][1], 0, 0, 0, 0x7f7f7f7f, 0, 0x7f7f7f7f); }
    }
    float mx = -INFINITY;
#pragma unroll
    for (int kt = 0; kt < 4; ++kt)
#pragma unroll
        for (int blk = 0; blk < 2; ++blk)
#pragma unroll
            for (int r = 0; r < 16; ++r) mx = fmaxf(mx, sc[kt][blk][r]);
    mx = fmaxf(mx, __shfl_xor(mx, 32));
    float ls = 0.f; bf16x8 pf[4][2][2];
#pragma unroll
    for (int kt = 0; kt < 4; ++kt)
#pragma unroll
        for (int blk = 0; blk < 2; ++blk) {
#pragma unroll
            for (int r = 0; r < 16; ++r) { const float e = fast_exp2(sc[kt][blk][r] - mx); sc[kt][blk][r] = e; ls += e; }
            pf[kt][blk][0] = packp(sc[kt][blk], 0); pf[kt][blk][1] = packp(sc[kt][blk], 1); }
    ls += __shfl_xor(ls, 32);
    if (hh == 0) wsf[r32] = fast_rcp(ls);
    const int vbase = (4 * hh + ((lane & 15) >> 2)) * XA_VS + (16 * ((lane >> 4) & 1) + 4 * (lane & 3)) * 2;
    char* opu = (char*)((bf16*)(C.ws + WS_C) + ((size_t)b * SEQ + 256 * qb + 32 * w) * 1024 + hd * 256);
    const unsigned oo = (unsigned)(4 * hh * 1024 + r32) * 2u;
#pragma unroll
    for (int pc = 0; pc < 2; ++pc) *(LAS u32x4*)(lds + XA_VT + (vrow + 32 * pc) * XA_VS + vch * 16) = vr[0][pc];
#pragma unroll
    for (int pc = 0; pc < 2; ++pc) vr[0][pc] = *(const u32x4*)(vgu + vo + (size_t)(64 * 2 + 32 * pc) * 4096);
    __syncthreads();
#pragma unroll 1
    for (int dh = 0; dh < 2; ++dh) {
        f32x16 o[4];
#pragma unroll
        for (int db = 0; db < 4; ++db) o[db] = f32x16{};
#pragma unroll
        for (int kt = 0; kt < 4; ++kt) {
            const int n = dh * 4 + kt;
            if (n < 7) {
#pragma unroll
                for (int pc = 0; pc < 2; ++pc) *(LAS u32x4*)(lds + XA_VT + ((kt + 1) & 1) * XA_VTB + (vrow + 32 * pc) * XA_VS + vch * 16) = vr[(kt + 1) & 1][pc];
                { const int n3 = (n + 3) & 7; const size_t nof = (size_t)(n3 >> 2) * 256 + (size_t)(64 * (n3 & 3)) * 4096;
#pragma unroll
                  for (int pc = 0; pc < 2; ++pc) vr[(kt + 1) & 1][pc] = *(const u32x4*)(vgu + vo + nof + (size_t)pc * 32 * 4096); } }
#pragma unroll
            for (int db = 0; db < 4; ++db)
#pragma unroll
                for (int blk = 0; blk < 2; ++blk)
#pragma unroll
                    for (int s2 = 0; s2 < 2; ++s2) { const LAS unsigned char* vp = lds + XA_VT + (kt & 1) * XA_VTB + vbase + (32 * blk + 16 * s2) * XA_VS + 64 * db;
                        o[db] = __builtin_amdgcn_mfma_f32_32x32x16_bf16(pf[kt][blk][s2], cat8(trread(vp), trread(vp + 8 * XA_VS)), o[db], 0, 0, 0); }
            __syncthreads();
        }
#pragma unroll
        for (int r = 0; r < 16; ++r) { const float fr = (wsf + 4 * hh)[CROW0(r)];
            if (XO_FP8) { LAS unsigned char* st = lds + XA_OST + w * 4096 + (4 * hh + CROW0(r)) * 128 + r32;
#pragma unroll
                for (int db = 0; db < 4; ++db) st[32 * db] = (unsigned char)(pk4_fp8(o[db][r] * fr * F8_XO_SCALE, 0.f, 0.f, 0.f) & 0xffu);
            } else { bf16* o2 = (bf16*)(opu + (size_t)CROW0(r) * 2048 + oo) + dh * 128;
#pragma unroll
                for (int db = 0; db < 4; ++db) o2[32 * db] = (bf16)f2bf(o[db][r] * fr); } }
        if (XO_FP8) { asm volatile("s_waitcnt lgkmcnt(0)" ::: "memory");
            unsigned char* x8 = C.ws + WS_C + ((size_t)b * SEQ + 256 * qb + 32 * w) * 1024 + hd * 256 + dh * 128;
#pragma unroll
            for (int it = 0; it < 4; ++it) { const int cid = lane + 64 * it, row = cid >> 3, ch = cid & 7; *(u32x4*)(x8 + (size_t)row * 1024 + ch * 16) = *(const LAS u32x4*)(lds + XA_OST + w * 4096 + row * 128 + ch * 16); }
            asm volatile("s_waitcnt lgkmcnt(0)" ::: "memory"); }
    }
}
__device__ __forceinline__ void phase_xattn(const Ctx& C) {
#ifndef XA_REP
#define XA_REP 1
#endif
    const int vcu = (C.G % 8 == 0) ? (C.bid % 8) * (C.G / 8) + C.bid / 8 : C.bid;
    for (int rep = 0; rep < XA_REP; ++rep)
    for (int L = vcu; L < NBATCH * XH * 8; L += C.G) xattn_unit(C, L >> 5, (L >> 3) & 3, L & 7);
}
constexpr int CTL_CNT = 64;
__device__ __forceinline__ void phase_router(const Ctx& C) {
    const int w = C.wave, lane = C.lane, r32 = lane & 31, hh = lane >> 5; const intab_t in = C.in;
    const bf16* h2b = (const bf16*)(C.ws + WS_H2); const bf16* wr = (const bf16*)(C.ws + WS_WR);
    unsigned* ctl = (unsigned*)(C.ws + WS_CTL); float* tokinfo = (float*)(C.ws + WS_TOKINFO);
    LAS float* LG = (LAS float*)C.lds + w * (32 * 65); LAS int* hist = (LAS int*)(C.lds + 8 * 32 * 65 * 4); LAS int* hbase = hist + 64;
    for (int base_task = C.bid * 8; base_task < T / 32; base_task += C.G * 8) {
        const int task = base_task + w; const size_t tok0 = (size_t)task * 32;
        if (C.tid < 64) hist[C.tid] = 0;
        __syncthreads();
        f32x16 acc[2] = {f32x16{}, f32x16{}}; float ss = 0.f;
        const bf16* ap = h2b + (tok0 + r32) * 1024 + 8 * hh; const bf16* bp = wr + (size_t)r32 * 1024 + 8 * hh;
#pragma unroll 8
        for (int s = 0; s < 64; ++s) { const bf16x8 a = *(const bf16x8*)(ap + 16 * s);
#pragma unroll
            for (int j = 0; j < 8; ++j) { const float x = bf2f((unsigned)(unsigned short)a[j]); ss += x * x; }
#pragma unroll
            for (int nb = 0; nb < 2; ++nb) { const bf16x8 bh = *(const bf16x8*)(bp + (size_t)nb * 32 * 1024 + 16 * s), bl = *(const bf16x8*)(bp + 65536 + (size_t)nb * 32 * 1024 + 16 * s);
                acc[nb] = __builtin_amdgcn_mfma_f32_32x32x16_bf16(a, bh, acc[nb], 0, 0, 0); acc[nb] = __builtin_amdgcn_mfma_f32_32x32x16_bf16(a, bl, acc[nb], 0, 0, 0); } }
        ss += __shfl_xor(ss, 32);
        const float rs = __builtin_amdgcn_rsqf(ss * (1.f / 1024.f) + EPS);
#pragma unroll
        for (int r = 0; r < 16; ++r) { (LG + 4 * hh * 65 + r32)[CROW0(r) * 65] = acc[0][r]; (LG + 4 * hh * 65 + r32)[CROW0(r) * 65 + 32] = acc[1][r]; }
        asm volatile("s_waitcnt lgkmcnt(0)" ::: "memory");
        int e0 = 0, e1 = 0, lp0 = 0, lp1 = 0; float w0 = 0.f, w1 = 0.f;
        if (hh == 0) {
            const LAS float* lg = LG + r32 * 65;
            float gl[4]; int gsel = 0; float gmax;
#pragma unroll
            for (int j = 0; j < 4; ++j) gl[j] = lg[j] * rs + in[34][j];
            gmax = gl[0];
#pragma unroll
            for (int j = 1; j < 4; ++j) if (gl[j] > gmax) { gmax = gl[j]; gsel = j; }
            float gsum = 0.f;
#pragma unroll
            for (int j = 0; j < 4; ++j) gsum += __expf(gl[j] - gmax);
            const float pg = 1.f / gsum;
            float el[8]; float m1 = -INFINITY, m2 = -INFINITY; int i1 = 0, i2 = 0;
#pragma unroll
            for (int j = 0; j < 8; ++j) el[j] = lg[4 + 8 * gsel + j] * rs + in[36][8 * gsel + j];
#pragma unroll
            for (int j = 0; j < 8; ++j) if (el[j] > m1) { m1 = el[j]; i1 = j; }
#pragma unroll
            for (int j = 0; j < 8; ++j) if (j != i1 && el[j] > m2) { m2 = el[j]; i2 = j; }
            const float x2 = __expf(m2 - m1); const float p1 = 1.f / (1.f + x2), p2 = x2 * p1;
            e0 = 8 * gsel + i1; e1 = 8 * gsel + i2; w0 = pg * p1; w1 = pg * p2;
            lp0 = atomicAdd((int*)&hist[e0], 1); lp1 = atomicAdd((int*)&hist[32 + e1], 1);
        }
        __syncthreads();
        if (C.tid < 64) { const int c = hist[C.tid]; hbase[C.tid] = c ? (int)atomicAdd(ctl + CTL_CNT + C.tid, (unsigned)c) : 0; }
        __syncthreads();
        if (hh == 0) { float* ti = tokinfo + (tok0 + r32) * 8;
            f32x4 a, b2; a.x = __int_as_float(e0); a.y = __int_as_float(e1); a.z = __int_as_float(hbase[e0] + lp0); a.w = __int_as_float(hbase[32 + e1] + lp1); b2.x = w0; b2.y = w1; b2.z = rs; b2.w = 0.f;
            *(f32x4*)ti = a; *(f32x4*)(ti + 4) = b2; }
        __syncthreads();
    }
}
__device__ __forceinline__ void phase_scatter(const Ctx& C) {
    const unsigned* ctl = (const unsigned*)(C.ws + WS_CTL); LAS int* off = (LAS int*)C.lds;
    MoeInfo* mi = (MoeInfo*)(C.ws + WS_MOEINFO);
    if (C.tid < 64) {
        const int l = C.tid; const int c = (int)__hip_atomic_load(ctl + CTL_CNT + l, __ATOMIC_RELAXED, __HIP_MEMORY_SCOPE_AGENT);
        const int ntl = (c + 255) >> 8; int incl = ntl;
#pragma unroll
        for (int d = 1; d < 64; d <<= 1) { const int t = __shfl_up(incl, d); if (l >= d) incl += t; }
        const int excl = incl - ntl; off[l] = excl << 8;
        const int t32 = __shfl(incl, 31), tot = __shfl(incl, 63);
        if (C.bid == 0) { for (int q = 0; q < ntl; ++q) mi->tile_exp[excl + q] = l & 31; if (l == 0) { mi->nt0 = t32; mi->nt1 = tot - t32; } } }
    __syncthreads();
    float* tokinfo = (float*)(C.ws + WS_TOKINFO);
    int* tokmap = (int*)(C.ws + WS_TOKMAP); float* wslot = (float*)(C.ws + WS_WSLOT); float* rsrow = (float*)(C.ws + WS_RSROW); unsigned* aoff = (unsigned*)(C.ws + WS_AOFF);
    for (int idx = C.bid * 512 + C.tid; idx < 2 * T; idx += C.G * 512) { const int tok = idx >> 1, sl = idx & 1;
        const f32x4 a = *(const f32x4*)(tokinfo + (size_t)tok * 8), b2 = *(const f32x4*)(tokinfo + (size_t)tok * 8 + 4);
        const int e0 = __float_as_int(a.x), e1 = __float_as_int(a.y), p0 = __float_as_int(a.z), p1 = __float_as_int(a.w);
        const int row = sl ? off[32 + e1] + p1 : off[e0] + p0;
        tokmap[row] = tok; wslot[row] = sl ? b2.y : b2.x; rsrow[row] = b2.z; aoff[row] = (unsigned)tok * (MOE_FP8 ? 1024u : 2048u);
    }
}

__device__ __forceinline__ void phase_combine(const Ctx& C) {
    const float* tokinfo = (const float*)(C.ws + WS_TOKINFO); const bf16* h2b = (const bf16*)(C.ws + WS_H2); const bf16* Y = (const bf16*)(C.ws + WS_Y);
    const int gw = C.bid * 8 + C.wave, NGW = C.G * 8;
    for (int tok0 = 2 * gw; tok0 < T; tok0 += 2 * NGW) {
        u32x4 hv[2][2], ya[2][2], yb[2][2];
#pragma unroll
        for (int q = 0; q < 2; ++q) { const int tok = tok0 + q; const f32x4 a = *(const f32x4*)(tokinfo + (size_t)tok * 8); const int r0 = __float_as_int(a.z), r1 = __float_as_int(a.w);
#pragma unroll
            for (int j = 0; j < 2; ++j) { hv[q][j] = ((const u32x4*)(h2b + (size_t)tok * 1024))[C.lane + 64 * j]; ya[q][j] = ((const u32x4*)(Y + (size_t)r0 * 1024))[C.lane + 64 * j]; yb[q][j] = ((const u32x4*)(Y + (size_t)r1 * 1024))[C.lane + 64 * j]; } }
#pragma unroll
        for (int q = 0; q < 2; ++q) { f32x4* op = (f32x4*)(C.out + (size_t)(tok0 + q) * 1024);
#pragma unroll
            for (int j = 0; j < 2; ++j) { const u32x4 h = hv[q][j], p = ya[q][j], r = yb[q][j]; f32x4 o0, o1;
                o0.x = bf2f(h.x & 0xffffu) + (bf2f(p.x & 0xffffu) + bf2f(r.x & 0xffffu)); o0.y = bf2f(h.x >> 16) + (bf2f(p.x >> 16) + bf2f(r.x >> 16));
                o0.z = bf2f(h.y & 0xffffu) + (bf2f(p.y & 0xffffu) + bf2f(r.y & 0xffffu)); o0.w = bf2f(h.y >> 16) + (bf2f(p.y >> 16) + bf2f(r.y >> 16));
                o1.x = bf2f(h.z & 0xffffu) + (bf2f(p.z & 0xffffu) + bf2f(r.z & 0xffffu)); o1.y = bf2f(h.z >> 16) + (bf2f(p.z >> 16) + bf2f(r.z >> 16));
                o1.z = bf2f(h.w & 0xffffu) + (bf2f(p.w & 0xffffu) + bf2f(r.w & 0xffffu)); o1.w = bf2f(h.w >> 16) + (bf2f(p.w >> 16) + bf2f(r.w >> 16));
                op[2 * (C.lane + 64 * j)] = o0; op[2 * (C.lane + 64 * j) + 1] = o1; } }
    }
}
#define XB_TMO      128
#define XB_XCNT(j)  (256  + 64 * (j))
#define XB_XSUB(j)  (1280 + 64 * (j))
#define XB_XGEN(j)  (2304 + 64 * (j))
#define XB_TOP      3328
#define XB_TOPGEN   3392
#define XCD_BAR_WORDS 3456
#define XB_SPIN_CAP (1u << 18)
__device__ __forceinline__ unsigned xb_ld(unsigned* p)              { return __hip_atomic_load(p, __ATOMIC_RELAXED, __HIP_MEMORY_SCOPE_AGENT); }
__device__ __forceinline__ unsigned xb_add(unsigned* p, unsigned v) { return __hip_atomic_fetch_add(p, v, __ATOMIC_RELAXED, __HIP_MEMORY_SCOPE_AGENT); }
__device__ __forceinline__ unsigned xb_xcc_id() { return (unsigned)__builtin_amdgcn_s_getreg((3 << 11) | 20) & 0xFu; }
#define XB_SPIN(cond, bar) do { unsigned _sp = 0; while (cond) { __builtin_amdgcn_s_sleep(1); \
    if ((++_sp & 255u) == 0u) { if (xb_ld(&(bar)[XB_TMO])) break; if (_sp > XB_SPIN_CAP) { atomicAdd(&(bar)[XB_TMO], 1u); break; } } } } while (0)
struct XcdBarrier { unsigned* bar; unsigned x; volatile LAS unsigned* st; };
__device__ __forceinline__ XcdBarrier xcd_barrier_post(unsigned* bar, volatile LAS unsigned* st) {
    XcdBarrier b; b.bar = bar; b.x = xb_xcc_id(); b.st = st;
    if (threadIdx.x == 0) (void)xb_add(&bar[XB_XCNT(b.x)], 1u);
    return b;
}
__device__ __forceinline__ void xcd_barrier_complete(unsigned* bar, unsigned x, unsigned& nloc, unsigned& nx) {
    const unsigned G = gridDim.x * gridDim.y * gridDim.z;
    unsigned sum, cnt, mine, sp = 0u;
    for (;;) {
        sum = 0u; cnt = 0u; mine = 0u;
#pragma unroll
        for (unsigned j = 0; j < 16; ++j) { const unsigned c = xb_ld(&bar[XB_XCNT(j)]); sum += c; cnt += (c > 0u) ? 1u : 0u; mine = (j == x) ? c : mine; }
        if (sum == G) break;
        __builtin_amdgcn_s_sleep(1);
        if ((++sp & 255u) == 0u) { if (xb_ld(&bar[XB_TMO])) break; if (sp > XB_SPIN_CAP) { atomicAdd(&bar[XB_TMO], 1u); break; } }
    }
    nloc = mine > 0u ? mine : 1u; nx = cnt > 0u ? cnt : 1u;
}
__device__ __forceinline__ void xcd_barrier(const XcdBarrier& b) {
    asm volatile("s_waitcnt vmcnt(0)" ::: "memory");
    __syncthreads();
    if (threadIdx.x == 0) {
        unsigned* bar = b.bar;
        __builtin_amdgcn_s_waitcnt(0);
        unsigned nloc = b.st[0], nx = b.st[1];
        if (nloc == 0u) { xcd_barrier_complete(bar, b.x, nloc, nx); b.st[0] = nloc; b.st[1] = nx; }
        const unsigned old = xb_add(&bar[XB_XSUB(b.x)], 1u);
        const unsigned gen = old / nloc;
        if (old + 1u == (gen + 1u) * nloc) {
            __builtin_amdgcn_fence(__ATOMIC_RELEASE, "agent");
            asm volatile("s_waitcnt vmcnt(0)" ::: "memory");
            const unsigned og = xb_add(&bar[XB_TOP], 1u);
            const unsigned tg = og / nx;
            if (og + 1u == (tg + 1u) * nx) xb_add(&bar[XB_TOPGEN], 1u);
            else XB_SPIN(xb_ld(&bar[XB_TOPGEN]) == tg, bar);
            __builtin_amdgcn_fence(__ATOMIC_ACQUIRE, "agent");
            xb_add(&bar[XB_XGEN(b.x)], 1u);
            asm volatile("s_waitcnt vmcnt(0)" ::: "memory");
        } else {
            XB_SPIN(xb_ld(&bar[XB_XGEN(b.x)]) == gen, bar);
            __builtin_amdgcn_fence(__ATOMIC_ACQUIRE, "agent");
            asm volatile("s_waitcnt vmcnt(0)" ::: "memory");
        }
    }
    __syncthreads();
}
constexpr int NPHASE = 15;
constexpr int LDS_BYTES = 163840;
template <int PH> __device__ __forceinline__ void run_phase(const Ctx& C0) {
    Ctx C = C0; asm volatile("" : "+v"(C.tid)); C.lane = C.tid & 63;
    unsigned char* ws = C.ws;
    const pg8::Gemm g1024{1024, 1024, 64}, g512{512, 512, 64}, g256{256, 256, 64}, gcmp{2048, 2048, 128};
    if constexpr (PH == 0) phase_prologue(C);
    if constexpr (PH == 1) {
        { SchedDense S; S.init(T, NPROJ_PAD, C.G, C.bid, ws + WS_A, 2048, ws + WS_WIN, 2048);
          EpiInProj E{ws};
          pg8::gemm_phase<EpiInProj, SchedDense>(C.lds, g1024, S, E);
#ifdef PROBE_G1_PLAIN
          { EpiPlain E2{(bf16*)(ws + WS_H1F8), 1024, 1.f}; pg8::gemm_phase<EpiPlain, SchedDense>(C.lds, g1024, S, E2); }
#endif
#ifdef PROBE_G1_FULL
          pg8::gemm_phase<EpiInProj, SchedDense>(C.lds, g1024, S, E);
#endif
          }
        { SchedDense S; S.init(TM, 2048, C.G, C.bid, ws + WS_MNB, XKV_FP8 ? 1024 : 2048, ws + WS_WKV, XKV_FP8 ? 1024 : 2048);
          EpiPlain E{(bf16*)(ws + WS_KVX), 2048, XKV_FP8 ? 1.f / F8_WKV_SCALE : 1.f};
          pg8::gemm_phase<EpiPlain, SchedDense, true, true, XKV_FP8 != 0>(C.lds, XKV_FP8 ? g512 : g1024, S, E); }
    }
    if constexpr (PH == 2) {
        { SchedCmp S{C.G, C.bid, (const char*)(ws + WS_KV6), (const char*)(ws + WS_KV6) + (size_t)T * 256, (const char*)(ws + WS_CW1)};
          EpiCmp1 E{(bf16*)(ws + WS_CMPHID), (const float*)(ws + WS_CB1P)};
          pg8::gemm_phase<EpiCmp1, SchedCmp>(C.lds, gcmp, S, E); }
        __syncthreads();
        pass_knorm(C);
#ifndef P2_SA
#define P2_SA 5
#define P2_SB 1
#define P2_SC 9
#endif
        static_assert(64 * P2_SA + 64 * P2_SB + 128 * P2_SC == 1536, "slab split");
        {
            const bool bal = (C.G == 256); const int kind = C.bid < 64 ? 0 : (C.bid < 128 ? 1 : 2);
            if (!bal || kind) phase_rg<false>(C, bal ? C.bid : -2, (bal && kind == 1) ? C.bid - 64 : -1);
            __syncthreads();
            if (bal) { const int s0 = kind == 0 ? C.bid * P2_SA : (kind == 1 ? 64 * P2_SA + (C.bid - 64) * P2_SB : 64 * (P2_SA + P2_SB) + (C.bid - 128) * P2_SC), sn = kind == 0 ? P2_SA : (kind == 1 ? P2_SB : P2_SC);
                phase_expert_weights_wg(C, s0, 1, s0 + sn); }
            else if (C.G > 64) { if (C.bid >= 64) phase_expert_weights_wg(C, C.bid - 64, C.G - 64); }
            else phase_expert_weights(C, C.bid * 8 + C.wave, C.G * 8);
        }
    }
    if constexpr (PH == 3) { phase_cmp2(C); phase_rg<true>(C); }
    if constexpr (PH == 4) phase_nsa(C);
    if constexpr (PH == 5) { }
    if constexpr (PH == 6) { SchedDense S; S.init(T, 1024, C.G, C.bid, ws + WS_C, 2048, ws + WS_WOUT, 2048);
        EpiOutMid E{(const bf16*)(ws + WS_A), (bf16*)(ws + WS_H1), (float*)(ws + WS_SSQH1), (const float*)(ws + WS_SSQRG), (const float*)(ws + WS_SSQNSA), XQ_FP8 ? ws + WS_H1F8 : nullptr};
        pg8::gemm_phase<EpiOutMid, SchedDense>(C.lds, g1024, S, E); }
    if constexpr (PH == 7) { SchedDense S; S.init(T, 1024, C.G, C.bid, XQ_FP8 ? ws + WS_H1F8 : ws + WS_H1, XQ_FP8 ? 1024 : 2048, ws + WS_WQ, XQ_FP8 ? 1024 : 2048);
        EpiPlain E{(bf16*)(ws + WS_A), 1024, XQ_FP8 ? 1.f / F8_WQ_SCALE : 1.f};
        pg8::gemm_phase<EpiPlain, SchedDense, true, true, XQ_FP8 != 0>(C.lds, XQ_FP8 ? g512 : g1024, S, E); }
    if constexpr (PH == 8) phase_xattn(C);
    if constexpr (PH == 9) { SchedDense S; S.init(T, 1024, C.G, C.bid, ws + WS_C, XO_FP8 ? 1024 : 2048, ws + WS_WO, XO_FP8 ? 1024 : 2048);
        EpiRes E{(const bf16*)(ws + WS_H1), (bf16*)(ws + WS_H2), nullptr, MOE_FP8 ? ws + WS_H2F8 : nullptr, XO_FP8 ? 1.f / (F8_WO_SCALE * F8_XO_SCALE) : 1.f};
        pg8::gemm_phase<EpiRes, SchedDense, true, true, XO_FP8 != 0>(C.lds, XO_FP8 ? g512 : g1024, S, E); }
    if constexpr (PH == 10) phase_router(C);
    if constexpr (PH == 11) phase_scatter(C);
    const MoeInfo* mi = (const MoeInfo*)(ws + WS_MOEINFO);
    constexpr size_t EB = MOE_FP8 ? 1 : 2;
    if constexpr (PH == 12) { const int nt0 = mi->nt0, nt1 = mi->nt1;
        SchedMoeT<true> S{C.G, C.bid, 0, nt0 + nt1, mi->tile_exp, (const char*)(ws + (MOE_FP8 ? WS_H2F8 : WS_H2)), (const char*)(ws + WS_W13), 0, (size_t)256 * 1024 * EB, (const unsigned*)(ws + WS_AOFF)};
        EpiMoe1 E{ws + WS_C, (const float*)(ws + WS_WSLOT), (const float*)(ws + WS_RSROW)};
        pg8::gemm_phase<EpiMoe1, SchedMoeT<true>, true, true, MOE_FP8 != 0>(C.lds, MOE_FP8 ? g512 : g1024, S, E); }
    if constexpr (PH == 13) { const int nt0 = mi->nt0;
        SchedMoeT<false> S{C.G, C.bid, 0, nt0, mi->tile_exp, (const char*)(ws + WS_C), (const char*)(ws + WS_W2), (size_t)256 * 512 * EB, (size_t)256 * 512 * EB, nullptr};
        EpiMoe2<0> E{(const int*)(ws + WS_TOKMAP), (const bf16*)(ws + WS_H2), (bf16*)(ws + WS_A), C.out};
        pg8::gemm_phase<EpiMoe2<0>, SchedMoeT<false>, true, true, MOE_FP8 != 0>(C.lds, MOE_FP8 ? g256 : g512, S, E); }
    if constexpr (PH == 14) { const int nt0 = mi->nt0, nt1 = mi->nt1;
        SchedMoeT<false> S{C.G, C.bid, nt0, nt1, mi->tile_exp, (const char*)(ws + WS_C), (const char*)(ws + WS_W2), (size_t)256 * 512 * EB, (size_t)256 * 512 * EB, nullptr};
        EpiMoe2<1> E{(const int*)(ws + WS_TOKMAP), (const bf16*)(ws + WS_A), (bf16*)(ws + WS_A), C.out};
        pg8::gemm_phase<EpiMoe2<1>, SchedMoeT<false>, true, true, MOE_FP8 != 0>(C.lds, MOE_FP8 ? g256 : g512, S, E); }
}
#ifndef DUP_PHASE
#define DUP_PHASE -1
#endif
__global__ void __launch_bounds__(512, 2) hymba_fwd(Args args) {
    extern __shared__ __attribute__((aligned(16))) unsigned char lds_raw[];
    const __attribute__((address_space(4))) unsigned char* ka = (const __attribute__((address_space(4))) unsigned char*)__builtin_amdgcn_kernarg_segment_ptr(); asm volatile("" : "+s"(ka));
    Ctx C; C.in = (intab_t)ka; C.out = args.out; C.ws = args.ws; C.lds = (LAS unsigned char*)lds_raw; C.tid = threadIdx.x; C.lane = C.tid & 63; C.wave = __builtin_amdgcn_readfirstlane(C.tid >> 6); C.G = gridDim.x; C.bid = blockIdx.x;
    const int lo = args.lo, hi = args.hi;
    volatile LAS unsigned* bst = (volatile LAS unsigned*)(C.lds + LDS_BYTES - 64);
    if (C.tid < 2) bst[C.tid] = 0u;
    __syncthreads();
    const XcdBarrier xbar = xcd_barrier_post((unsigned*)(args.ws + WS_CTL + 16384), bst);
#define IN(k) (lo <= (k) && (k) < hi)
#define GBAR(k) xcd_barrier(xbar)
#ifndef PHMASK
#define PHMASK 0x7fff
#endif
#define PHSEL(k) (((PHMASK) >> (k)) & 1)
#define PHASE(k) do { if (PHSEL(k) && IN(k)) { run_phase<k>(C); if (DUP_PHASE == (k)) { xcd_barrier(xbar); run_phase<k>(C); } } if (IN(k) && (k) + 1 < hi) GBAR(k); } while (0)
    PHASE(0); PHASE(1); PHASE(2); PHASE(3); PHASE(4); PHASE(6); PHASE(7); PHASE(8); PHASE(9); PHASE(10); PHASE(11); PHASE(12); PHASE(13); PHASE(14);
#undef IN
#undef PHASE
#undef GBAR
}

#ifndef N_LAUNCH_MODE
#define N_LAUNCH_MODE 0
#endif
extern "C" void kernel_launch(void* const* d_in, const int* in_sizes, int n_in, void* d_out, int out_size, void* d_ws, size_t ws_size, hipStream_t stream) {
    static int grid = 0;
    if (grid == 0) {
        if (n_in != 40 || out_size != T * DM || ws_size < WS_END) { fprintf(stderr, "kernel_launch: unexpected problem (n_in %d out %d ws %zu)\n", n_in, out_size, ws_size); grid = -1; return; }
        int dev = 0, cus = 0, per_cu = 0;
        if (hipGetDevice(&dev) != hipSuccess || hipDeviceGetAttribute(&cus, hipDeviceAttributeMultiprocessorCount, dev) != hipSuccess) { grid = -1; return; }
        if (hipFuncSetAttribute((const void*)hymba_fwd, hipFuncAttributeMaxDynamicSharedMemorySize, LDS_BYTES) != hipSuccess) { fprintf(stderr, "kernel_launch: hipFuncSetAttribute failed\n"); grid = -1; return; }
        if (hipOccupancyMaxActiveBlocksPerMultiprocessor(&per_cu, (const void*)hymba_fwd, 512, LDS_BYTES) != hipSuccess || per_cu < 1) { fprintf(stderr, "kernel_launch: occupancy query says %d\n", per_cu); (void)hipGetLastError(); }
        grid = cus;
    }
    if (grid < 0) return;
    (void)hipMemsetAsync((char*)d_ws + WS_CTL, 0, CTL_BYTES, stream);
    Args a{};
    for (int i = 0; i < 40; ++i) a.in[i] = (const float*)d_in[i];
    a.out = (float*)d_out; a.ws = (unsigned char*)d_ws;
#if N_LAUNCH_MODE == 0
    a.lo = 0; a.hi = NPHASE;
    void* kargs[] = {&a};
    hipError_t e = hipLaunchCooperativeKernel((const void*)hymba_fwd, dim3(grid), dim3(512), kargs, LDS_BYTES, stream);
    if (e != hipSuccess) fprintf(stderr, "cooperative launch failed: %s (grid %d)\n", hipGetErrorString(e), grid);
#else
    for (int ph = 0; ph < NPHASE; ++ph) { a.lo = ph; a.hi = ph + 1; hipLaunchKernelGGL(hymba_fwd, dim3(grid), dim3(512), LDS_BYTES, stream, a); }
#endif
}
```

```cpp
#include <hip/hip_runtime.h>
#include <hip/hip_cooperative_groups.h>
#include <cstdio>
#include <cstdint>
#include <type_traits>
namespace cg = cooperative_groups;

#define GAS __attribute__((address_space(1)))
#define LAS __attribute__((address_space(3)))
typedef unsigned short bf16;
typedef short bf16x8 __attribute__((ext_vector_type(8)));
typedef short s16x4 __attribute__((ext_vector_type(4)));
typedef float f32x4 __attribute__((ext_vector_type(4)));
typedef float f32x16 __attribute__((ext_vector_type(16)));
typedef unsigned u32x4 __attribute__((ext_vector_type(4)));
typedef unsigned u32x2 __attribute__((ext_vector_type(2)));

constexpr int DM = 1024, NBATCH = 32, SEQ = 2048, T = NBATCH * SEQ;
constexpr int RGW = 512, NSAW = 512, HD = 64, NH = 8, NKV = 2, KVW = 128;
constexpr int NPROJ = 2328, NPROJ_PAD = 2560;
constexpr int NCMP = 127, NCMP_PAD = 128, CMP_HID = 256;
constexpr int MEML = 256, XH = 4, XHD = 256, TM = NBATCH * MEML;
constexpr int NEXP = 32, DEXP = 512;
constexpr float EPS = 1e-6f;
constexpr float LOG2E = 1.4426950408889634f;
constexpr float QSCALE = 0.125f * LOG2E;
constexpr float XQSCALE = 0.0625f * LOG2E;
constexpr int MOE_MAXT = 288;
constexpr int MOE_ROWS = 2 * MOE_MAXT * 256;

__device__ __forceinline__ float bf2f(unsigned v) { return __uint_as_float(v << 16); }
__device__ __forceinline__ unsigned f2bf(float f) { unsigned u = __float_as_uint(f); return (u + 0x7fffu + ((u >> 16) & 1u)) >> 16; }
__device__ __forceinline__ unsigned pk2(float lo, float hi) { unsigned r; asm volatile("v_cvt_pk_bf16_f32 %0, %1, %2" : "=v"(r) : "v"(lo), "v"(hi)); return r; }
__device__ __forceinline__ float fast_exp2(float x) { return __builtin_amdgcn_exp2f(x); }
__device__ __forceinline__ float fast_rcp(float x) { return __builtin_amdgcn_rcpf(x); }
__device__ __forceinline__ float sigmoidf_(float x) { return fast_rcp(1.f + fast_exp2(-x * LOG2E)); }
__device__ __forceinline__ float gelu_tanh(float x) { const float p = __builtin_fmaf(x * x, -2.3022082f * 0.044715f, -2.3022082f); return x * fast_rcp(1.f + fast_exp2(x * p)); }
__device__ __forceinline__ float silu_(float x) { return x * sigmoidf_(x); }
__device__ __forceinline__ float wave_sum(float v) {
#pragma unroll
    for (int o = 1; o < 64; o <<= 1) v += __shfl_xor(v, o);
    return v;
}
template <int CTRL, int ROWMASK = 0xf> __device__ __forceinline__ float dpp_add(float v) { return v + __int_as_float(__builtin_amdgcn_update_dpp(0, __float_as_int(v), CTRL, ROWMASK, 0xf, true)); }
__device__ __forceinline__ float half_sum_dpp(float s) { s = dpp_add<0xB1>(s); s = dpp_add<0x4E>(s); s = dpp_add<0x141>(s); s = dpp_add<0x140>(s); return dpp_add<0x142, 0xA>(s); }
__device__ const unsigned char kBucket[128] = {0, 1, 2, 3, 4, 5, 6, 7, 8, 9, 10, 11, 12, 13, 14, 15, 16, 16, 16, 17, 17, 18, 18, 18, 19, 19, 19, 20, 20, 20, 20, 21, 21, 21, 21, 22, 22, 22, 22, 22, 23, 23, 23, 23, 23, 23, 24, 24, 24, 24, 24, 24, 25, 25, 25, 25, 25, 25, 25, 26, 26, 26, 26, 26, 26, 26, 26, 27, 27, 27, 27, 27, 27, 27, 27, 27, 27, 28, 28, 28, 28, 28, 28, 28, 28, 28, 28, 29, 29, 29, 29, 29, 29, 29, 29, 29, 29, 29, 29, 30, 30, 30, 30, 30, 30, 30, 30, 30, 30, 30, 30, 30, 30, 31, 31, 31, 31, 31, 31, 31, 31, 31, 31, 31, 31, 31, 31, 31};

__device__ __forceinline__ unsigned pk4_fp8(float a, float b, float c, float d) { unsigned w = 0;
    a = __builtin_amdgcn_fmed3f(a, -448.f, 448.f); b = __builtin_amdgcn_fmed3f(b, -448.f, 448.f); c = __builtin_amdgcn_fmed3f(c, -448.f, 448.f); d = __builtin_amdgcn_fmed3f(d, -448.f, 448.f); w = __builtin_amdgcn_cvt_pk_fp8_f32(a, b, w, false); w = __builtin_amdgcn_cvt_pk_fp8_f32(c, d, w, true); return w; }
#ifndef MOE_FP8
#define MOE_FP8 1
#endif
#ifndef XQ_FP8
#define XQ_FP8 1
#endif
#ifndef XO_FP8
#define XO_FP8 1
#endif
#ifndef WOUT_FP8
#define WOUT_FP8 1
#endif
#ifndef XKV_FP8
#define XKV_FP8 1
#endif
constexpr float F8_WKV_SCALE = 32.f;
constexpr float F8_MIX_SCALE = 16.f, F8_WOUT_SCALE = 32.f;
constexpr float F8_WQ_SCALE = 32.f, F8_WO_SCALE = 32.f, F8_XO_SCALE = 16.f;
constexpr float F8_W13_SCALE = MOE_FP8 ? 32.f : 1.f, F8_W2_SCALE = MOE_FP8 ? 16.f : 1.f, F8_H_SCALE = MOE_FP8 ? 8.f : 1.f;

__device__ __forceinline__ void glds16(const void* gsrc, unsigned lds_dst) { unsigned keep;
    asm volatile("s_mov_b32 %0, m0\n\ts_mov_b32 m0, %2\n\ts_nop 0\n\tglobal_load_lds_dwordx4 %1, off\n\ts_mov_b32 m0, %0" : "=&s"(keep) : "v"(gsrc), "s"(lds_dst) : "memory"); }
namespace pg8 {
#define PG8_LAS __attribute__((address_space(3)))
typedef unsigned short bf16_t;
typedef short bf16x8 __attribute__((ext_vector_type(8)));
typedef float f32x4 __attribute__((ext_vector_type(4)));
typedef unsigned u32x4 __attribute__((ext_vector_type(4)));
typedef unsigned u32x2 __attribute__((ext_vector_type(2)));
constexpr int BM = 256, BK = 64, HALF = 128, HTB = HALF * BK * 2  , STAGE_BYTES = 8 * HTB, NXCD = 8, WGM = 8;

__host__ __device__ __forceinline__ int lds_byte(int r, int c) { const int st = (r >> 4) * 2 + (c >> 5), rr = r & 15, cc = c & 31, ob = rr * 64 + cc * 2; return st * 1024 + (ob ^ (((ob >> 9) & 1) << 5)); }
__host__ __device__ __forceinline__ void stage_rc(int b, int& R, int& C) { const int st = b / 1024, sb = b % 1024, swz = sb ^ (((sb >> 9) & 1) << 5); R = (st >> 1) * 16 + swz / 64; C = (st & 1) * 32 + (swz % 64) / 2; }
__host__ __device__ __forceinline__ int perm32(int rho) { const int n = rho >> 4, i = rho & 15; return 8 * (i >> 2) + 4 * n + (i & 3); }

struct Unit { int pm, pn, aux; };
struct Gemm { int K; int lda; int kstepA; };

__device__ __forceinline__ unsigned cvt_pk_bf16(float lo, float hi) { unsigned r; asm volatile("v_cvt_pk_bf16_f32 %0, %1, %2" : "=v"(r) : "v"(lo), "v"(hi)); return r; }

typedef int v8i32 __attribute__((ext_vector_type(8)));
typedef int v4i32 __attribute__((ext_vector_type(4)));
template <class Epi, class Sched, bool ALIGN_EPI = true, bool SP2 = true, bool F8 = false>
__device__ __forceinline__ void gemm_phase(PG8_LAS unsigned char* lds, const Gemm g, const Sched& S, const Epi& E) {
    const int tid = threadIdx.x, wid = __builtin_amdgcn_readfirstlane(tid >> 6), lane = tid & 63, wr = wid >> 2, wc = wid & 3, fr = lane & 15, fq = lane >> 4;
    const int K = g.K, nt = K / BK;
    unsigned voffA[2], voffB[2]; int growA[2];
#pragma unroll
    for (int i = 0; i < 2; ++i) { int R, C; stage_rc(tid * 16 + i * 8192, R, C); const int Rb = Epi::PERM ? ((R & ~31) + perm32(R & 31)) : R;
        voffA[i] = (unsigned)(R * g.lda + C) * 2u; voffB[i] = (unsigned)(Rb * K + C) * 2u; growA[i] = R; if constexpr (Sched::GATHER) voffA[i] = (unsigned)C * 2u; }
    const size_t kstepA = (size_t)g.kstepA * 2, kstepB = (size_t)(BK * 2);
    const size_t hstepA = (size_t)HALF * g.lda * 2, hstepB = (size_t)HALF * K * 2;
    const unsigned ldsw = (unsigned)wid * 1024u;
    const int aoff = lds_byte(wr * 64 + fr, fq * 8), boff = lds_byte(wc * 32 + fr, fq * 8);
#define PG8_SA(b, h) (((b) * 2 + (h)) * HTB)
#define PG8_SB(b, h) ((4 + (b) * 2 + (h)) * HTB)
#define PG8_STAGE(bufoff, gbase, voff) do { _Pragma("unroll") for (int _i = 0; _i < 2; ++_i) \
        __builtin_amdgcn_global_load_lds((const unsigned*)((const char*)(gbase) + (voff)[_i]), (PG8_LAS unsigned*)(lds + (bufoff) + ldsw + _i * 8192), 16, 0, 0); } while (0)
#define PG8_STAGE_G(bufoff, kbyte, go) do { _Pragma("unroll") for (int _i = 0; _i < 2; ++_i) \
        __builtin_amdgcn_global_load_lds((const unsigned*)(cA + (kbyte) + (go)[_i]), (PG8_LAS unsigned*)(lds + (bufoff) + ldsw + _i * 8192), 16, 0, 0); } while (0)
#define PG8_STAGE_A(bufoff, h, plainptr, kbyte, gsel) do { if constexpr (Sched::GATHER) PG8_STAGE_G(bufoff, kbyte, (gsel)[h]); else PG8_STAGE(bufoff, plainptr, voffA); } while (0)
#define PG8_LD1(dst, addr) do { if constexpr (F8) { const v4i32 _lo = *(const PG8_LAS v4i32*)(addr), _hi = *(const PG8_LAS v4i32*)((addr) + 1024); (dst).v = __builtin_shufflevector(_lo, _hi, 0, 1, 2, 3, 4, 5, 6, 7); } \
        else { (dst)[0] = *(const PG8_LAS bf16x8*)(addr); (dst)[1] = *(const PG8_LAS bf16x8*)((addr) + 1024); } } while (0)
#define PG8_LDA(dst, b, h) do { _Pragma("unroll") for (int m = 0; m < 4; ++m) PG8_LD1(dst[m], lds + PG8_SA(b, h) + aoff + m * 2048); } while (0)
#define PG8_LDB(dst, b, h) do { _Pragma("unroll") for (int n = 0; n < 2; ++n) PG8_LD1(dst[n], lds + PG8_SB(b, h) + boff + n * 2048); } while (0)
#define PG8_MMA(ai, bj, At, Bt) do { __builtin_amdgcn_s_setprio(1); \
        if constexpr (F8) { _Pragma("unroll") for (int m = 0; m < 4; ++m) _Pragma("unroll") for (int n = 0; n < 2; ++n) \
            asm volatile("v_mfma_scale_f32_16x16x128_f8f6f4 %0, %1, %2, %0, %3, %3 op_sel_hi:[0,0,0]" : "+v"(acc[ai][bj][m][n]) : "v"(Bt[n].v), "v"(At[m].v), "v"(f8one)); } \
        else { _Pragma("unroll") for (int m = 0; m < 4; ++m) _Pragma("unroll") for (int n = 0; n < 2; ++n) _Pragma("unroll") for (int k = 0; k < 2; ++k) \
            acc[ai][bj][m][n] = __builtin_amdgcn_mfma_f32_16x16x32_bf16(Bt[n][k], At[m][k], acc[ai][bj][m][n], 0, 0, 0); } \
        __builtin_amdgcn_s_setprio(0); } while (0)
#define PG8_WAIT_V(n) asm volatile("s_waitcnt vmcnt(" #n ")" ::: "memory")
#define PG8_WAIT_L(n) asm volatile("s_waitcnt lgkmcnt(" #n ")" ::: "memory")
#define PG8_BAR __builtin_amdgcn_s_barrier()
#define PG8_SCHED __builtin_amdgcn_sched_barrier(0)
    Unit cur, nxt; int ui = 0;
    if (!S.next(0, cur)) return;
    f32x4 acc[2][2][4][2];
#pragma unroll
    for (int a = 0; a < 2; ++a)
#pragma unroll
        for (int b = 0; b < 2; ++b)
#pragma unroll
            for (int m = 0; m < 4; ++m)
#pragma unroll
                for (int n = 0; n < 2; ++n) acc[a][b][m][n] = (f32x4){0.f, 0.f, 0.f, 0.f};
    const unsigned f8one = 0x7f7f7f7fu;
    typedef bf16x8 frag_t[2];
    struct Frag8 { v8i32 v; };
    typename std::conditional<F8, Frag8, frag_t>::type At[4], B0[2], B1[2];
    const char* cA = S.a_base(cur); const char* cB = S.b_base(cur);
    unsigned goff[2][2] = {{0u, 0u}, {0u, 0u}}, gnext[2][2] = {{0u, 0u}, {0u, 0u}};
    if constexpr (Sched::GATHER) {
#pragma unroll
        for (int h = 0; h < 2; ++h)
#pragma unroll
            for (int i = 0; i < 2; ++i) goff[h][i] = S.row_off(cur, h * HALF + growA[i]) + voffA[i]; }
    static_assert(SP2, "only the SP2 loop is kept in this file");
    if constexpr (Epi::MIDK) E.unit_begin(cur, ui, lds, tid);
    PG8_STAGE(PG8_SB(0, 0), cB, voffB); PG8_STAGE(PG8_SB(0, 1), cB + hstepB, voffB); PG8_STAGE_A(PG8_SA(0, 0), 0, cA, 0, goff); PG8_STAGE_A(PG8_SA(0, 1), 1, cA + hstepA, 0, goff);
    if (wr == 1) PG8_BAR;
    PG8_WAIT_V(2); PG8_BAR;
    PG8_STAGE(PG8_SB(1, 0), cB + kstepB, voffB); PG8_STAGE_A(PG8_SA(1, 0), 0, cA + kstepA, kstepA, goff); PG8_STAGE(PG8_SB(1, 1), cB + hstepB + kstepB, voffB);
    PG8_WAIT_V(6); PG8_BAR;
    for (;;) {
        const bool has_next = S.next(ui + 1, nxt);
        const char* nA = has_next ? S.a_base(nxt) : cA; const char* nB = has_next ? S.b_base(nxt) : cB;
        if constexpr (Sched::GATHER) {
#pragma unroll
            for (int h = 0; h < 2; ++h)
#pragma unroll
                for (int i = 0; i < 2; ++i) gnext[h][i] = has_next ? S.row_off(nxt, h * HALF + growA[i]) + voffA[i] : goff[h][i]; }
#pragma unroll 1
        for (int t = 0; t < nt; t += 2) {
            const bool last = (t == nt - 2);
            const char* a1 = cA + (size_t)(t + 1) * kstepA;
            const char* a2 = last ? nA : cA + (size_t)(t + 2) * kstepA; const char* b2 = last ? nB : cB + (size_t)(t + 2) * kstepB;
            const char* a3 = a2 + kstepA; const char* b3 = b2 + kstepB;
            const size_t k1 = (size_t)(t + 1) * kstepA, k2 = last ? 0 : (size_t)(t + 2) * kstepA, k3 = k2 + kstepA;
            unsigned gs[2][2];
#pragma unroll
            for (int h = 0; h < 2; ++h)
#pragma unroll
                for (int i = 0; i < 2; ++i) gs[h][i] = last ? gnext[h][i] : goff[h][i];
            if constexpr (Epi::MIDK) { if (t == nt / 2) { if constexpr (F8) asm volatile("s_nop 15\n\ts_nop 7" ::: "memory");
                E.midk(acc, cur, ui, lds, wr, wc, fr, fq); if constexpr (F8) asm volatile("s_nop 7" ::: "memory");
                if (has_next) E.unit_begin(nxt, ui + 1, lds, tid); } }
            PG8_LDB(B0, 0, 0); PG8_LDB(B1, 0, 1); PG8_SCHED; PG8_LDA(At, 0, 0); PG8_STAGE_A(PG8_SA(1, 1), 1, a1 + hstepA, k1, goff);
            PG8_WAIT_V(8); PG8_WAIT_L(0); PG8_BAR; PG8_MMA(0, 0, At, B0); PG8_MMA(0, 1, At, B1); PG8_BAR; PG8_SCHED;
            PG8_LDA(At, 0, 1); PG8_STAGE(PG8_SB(0, 0), b2, voffB); PG8_STAGE(PG8_SB(0, 1), b2 + hstepB, voffB); PG8_STAGE_A(PG8_SA(0, 0), 0, a2, k2, gs);
            PG8_WAIT_V(8); PG8_WAIT_L(0); PG8_BAR; PG8_MMA(1, 0, At, B0); PG8_MMA(1, 1, At, B1); PG8_BAR; PG8_SCHED;
            PG8_LDB(B0, 1, 0); PG8_LDB(B1, 1, 1); PG8_SCHED; PG8_LDA(At, 1, 0); PG8_STAGE_A(PG8_SA(0, 1), 1, a2 + hstepA, k2, gs);
            PG8_WAIT_V(8); PG8_WAIT_L(0); PG8_BAR; PG8_MMA(0, 0, At, B0); PG8_MMA(0, 1, At, B1); PG8_BAR; PG8_SCHED;
            PG8_LDA(At, 1, 1); PG8_STAGE(PG8_SB(1, 0), b3, voffB); PG8_STAGE(PG8_SB(1, 1), b3 + hstepB, voffB); PG8_STAGE_A(PG8_SA(1, 0), 0, a3, k3, gs);
            PG8_WAIT_V(8); PG8_WAIT_L(0); PG8_BAR; PG8_MMA(1, 0, At, B0); PG8_MMA(1, 1, At, B1); PG8_BAR; PG8_SCHED;
        }
        if constexpr (F8) asm volatile("s_nop 15\n\ts_nop 7" ::: "memory");
        if constexpr (F8) {
#pragma unroll
            for (int a = 0; a < 2; ++a)
#pragma unroll
                for (int b = 0; b < 2; ++b)
#pragma unroll
                    for (int m = 0; m < 4; ++m)
#pragma unroll
                        for (int n = 0; n < 2; ++n) asm volatile("" : "+v"(acc[a][b][m][n])); }
        if constexpr (ALIGN_EPI) { if (wr == 0) PG8_BAR; }
        if constexpr (Epi::MIDK) E.fin(acc, cur, ui, lds, wr, wc, fr, fq); else E(acc, cur, wr, wc, fr, fq);
        if (!has_next) break;
#pragma unroll
        for (int a = 0; a < 2; ++a)
#pragma unroll
            for (int b = 0; b < 2; ++b)
#pragma unroll
                for (int m = 0; m < 4; ++m)
#pragma unroll
                    for (int n = 0; n < 2; ++n) acc[a][b][m][n] = (f32x4){0.f, 0.f, 0.f, 0.f};
        cur = nxt; cA = nA; cB = nB; ++ui;
        if constexpr (Sched::GATHER) {
#pragma unroll
            for (int h = 0; h < 2; ++h)
#pragma unroll
                for (int i = 0; i < 2; ++i) goff[h][i] = gnext[h][i]; }
        if constexpr (ALIGN_EPI) { if (wr == 1) PG8_BAR; }
    }
    PG8_WAIT_V(0);
    if constexpr (!ALIGN_EPI) { if (wr == 0) PG8_BAR; }
    PG8_BAR;
#undef PG8_SA
#undef PG8_SB
#undef PG8_STAGE
#undef PG8_STAGE_G
#undef PG8_STAGE_A
#undef PG8_LDA
#undef PG8_LDB
#undef PG8_MMA
#undef PG8_LD1
#undef PG8_WAIT_V
#undef PG8_WAIT_L
#undef PG8_BAR
#undef PG8_SCHED
}
}
constexpr size_t MiB = 1u << 20;
constexpr size_t WS_CTL = 0, CTL_BYTES = 64 * 1024;
constexpr size_t WS_RSX = 1 * MiB;
constexpr size_t WS_BIAS2 = WS_RSX + 256 * 1024;
constexpr size_t WS_CB1P = WS_BIAS2 + 8192;
constexpr size_t WS_MOEINFO = WS_CB1P + 32768;
constexpr size_t WS_GTAB = WS_MOEINFO + 8192;
constexpr size_t WS_AOFF = 1 * MiB + 384 * 1024;
constexpr size_t WS_SSQRG = 14 * MiB, WS_SSQNSA = 16 * MiB;
constexpr size_t WS_RSROW = 35 * MiB;
constexpr size_t WS_SSQH1 = 2 * MiB;
constexpr size_t WS_GATES = 6 * MiB;
constexpr size_t WS_RGSUM = 12 * MiB;
constexpr size_t WS_KCMP = 20 * MiB, WS_VCMP = 21 * MiB;
constexpr size_t WS_RGW = 22 * MiB + 512 * 1024;
constexpr size_t WS_WR = 22 * MiB;
constexpr size_t WS_TOKINFO = 23 * MiB;
constexpr size_t WS_TOKMAP = 25 * MiB, WS_WSLOT = 26 * MiB;
constexpr size_t WS_CMPHID = 27 * MiB;
constexpr size_t WS_WIN = 36 * MiB, WS_WOUT = 41 * MiB, WS_WQ = 43 * MiB, WS_WKV = 45 * MiB, WS_WO = 49 * MiB, WS_CW1 = 51 * MiB;
constexpr size_t WS_W13 = 53 * MiB, WS_W2 = 117 * MiB;
constexpr size_t WS_A = 150 * MiB;
constexpr size_t WS_B = 278 * MiB;
constexpr size_t WS_U = WS_B, WS_GATE = WS_B + 64 * MiB, WS_Q = WS_B + 128 * MiB, WS_KV6 = WS_B + 192 * MiB;
constexpr size_t WS_H1 = WS_B, WS_H2 = WS_B + 128 * MiB;
constexpr size_t WS_C = 567 * MiB;
constexpr size_t WS_D = 712 * MiB;
constexpr size_t WS_MNB = WS_D, WS_KVX = WS_D + 16 * MiB;
constexpr size_t WS_H2F8 = WS_D;
constexpr size_t WS_H1F8 = WS_D + 64 * MiB;
constexpr size_t WS_Y = WS_D;
constexpr size_t WS_XK8 = WS_MNB;
constexpr size_t WS_END = WS_D + 288 * MiB;
static_assert(WS_KV6 + 96 * MiB + MiB <= WS_C && WS_C + 144 * MiB <= WS_D && WS_W2 + 32 * MiB <= WS_A && WS_A + 128 * MiB <= WS_B, "ws map");

using pg8::Unit;
struct SchedDense {
    static constexpr bool GATHER = false;
    int nM, nN, nwg, G, c; const char* A; const char* B; size_t tA, tB;
    __device__ __forceinline__ void init(int M, int N, int G_, int c_, const void* A_, size_t lda_bytes, const void* B_, size_t ldb_bytes) {
        nM = M / 256; nN = N / 256; nwg = nM * nN; G = G_; c = c_; A = (const char*)A_; B = (const char*)B_; tA = 256 * lda_bytes; tB = 256 * ldb_bytes; }
    __device__ __forceinline__ bool next(int i, Unit& u) const {
        const long L = (long)i * G + c; if (L >= nwg) return false;
        int wgid = (int)L; { const int q = nwg / 8, r = nwg % 8, xcd = wgid % 8, off = wgid / 8; wgid = (xcd < r ? xcd * (q + 1) : r * (q + 1) + (xcd - r) * q) + off; }
        const int nig = 8 * nN, gid = wgid / nig, fm = gid * 8, gsz = (nM - fm) < 8 ? (nM - fm) : 8;
        u.pm = fm + ((wgid % nig) % gsz); u.pn = (wgid % nig) / gsz; u.aux = 0; return true;
    }
    __device__ __forceinline__ const char* a_base(const Unit& u) const { return A + (size_t)u.pm * tA; }
    __device__ __forceinline__ const char* b_base(const Unit& u) const { return B + (size_t)u.pn * tB; }
};

struct EpiPlain {
    static constexpr bool PERM = true, MIDK = false;
    bf16* O; int ldc; float scale;
    __device__ __forceinline__ void operator()(const f32x4 (&acc)[2][2][4][2], const Unit& u, int wr, int wc, int fr, int fq) const {
        const int row0 = u.pm * 256 + wr * 64 + fr, col0 = u.pn * 256 + wc * 32 + 8 * fq;
#pragma unroll
        for (int ai = 0; ai < 2; ++ai)
#pragma unroll
            for (int m = 0; m < 4; ++m) { bf16* rowp = O + (size_t)(row0 + ai * 128 + m * 16) * ldc + col0;
#pragma unroll
                for (int bj = 0; bj < 2; ++bj) { const f32x4 v0 = acc[ai][bj][m][0] * scale, v1 = acc[ai][bj][m][1] * scale;
                    u32x4 w; w.x = pk2(v0[0], v0[1]); w.y = pk2(v0[2], v0[3]); w.z = pk2(v1[0], v1[1]); w.w = pk2(v1[2], v1[3]);
                    *(u32x4*)(rowp + bj * 128) = w; } }
    }
};

struct EpiInProj {
    static constexpr bool PERM = true, MIDK = false;
    unsigned char* ws;
    __device__ __forceinline__ void operator()(const f32x4 (&acc)[2][2][4][2], const Unit& un, int wr, int wc, int fr, int fq) const {
        const int pn = un.pn; const int row0 = un.pm * 256 + wr * 64 + fr;
        const float* rs_x = (const float*)(ws + WS_RSX);
        if (pn < 4) {
            bf16* dst = (bf16*)(ws + WS_U + (size_t)(pn >> 1) * (64 * MiB)) + (pn & 1) * 256 + wc * 32 + 8 * fq;
#pragma unroll
            for (int ai = 0; ai < 2; ++ai)
#pragma unroll
                for (int m = 0; m < 4; ++m) { const int row = row0 + ai * 128 + m * 16; const float rs = rs_x[row];
#pragma unroll
                    for (int bj = 0; bj < 2; ++bj) { const f32x4 v0 = acc[ai][bj][m][0] * rs, v1 = acc[ai][bj][m][1] * rs;
                        u32x4 w; w.x = pk2(v0[0], v0[1]); w.y = pk2(v0[2], v0[3]); w.z = pk2(v1[0], v1[1]); w.w = pk2(v1[2], v1[3]);
                        *(u32x4*)(dst + (size_t)row * 512 + bj * 128) = w; } }
        } else if (pn < 9) {
            size_t doff; int ld, gi; bool norm;
            if (pn < 6) { const int head = 4 * (pn - 4) + wc; doff = WS_Q + (size_t)head * 128; ld = 512; norm = true; gi = 0; }
            else { const int kind = pn - 6, isV = wc >> 1, g = wc & 1; doff = WS_KV6 + (size_t)(kind * 2 + isV) * ((size_t)T * 256) + g * 128; ld = 128; norm = (!isV && kind > 0); gi = kind; }
            bf16* dst = (bf16*)(ws + doff); const float* gain = (const float*)(ws + WS_GTAB) + gi * 64;
            const bool k8 = (pn >= 7) && (wc < 2);
            unsigned char* dst8 = ws + WS_KV6 + (size_t)((pn - 6) * 2) * ((size_t)T * 256) + (wc & 1) * 64;
            f32x4 gv[2][2];
#pragma unroll
            for (int bj = 0; bj < 2; ++bj)
#pragma unroll
                for (int n = 0; n < 2; ++n) { const f32x4 gl = *(const f32x4*)(gain + 32 * bj + 8 * fq + 4 * n); gv[bj][n] = norm ? gl : (f32x4){1.f, 1.f, 1.f, 1.f}; }
#pragma unroll
            for (int ai = 0; ai < 2; ++ai)
#pragma unroll
                for (int m = 0; m < 4; ++m) { const int row = row0 + ai * 128 + m * 16; const float rs = rs_x[row];
                    f32x4 v[2][2]; float ss = 0.f;
#pragma unroll
                    for (int bj = 0; bj < 2; ++bj)
#pragma unroll
                        for (int n = 0; n < 2; ++n) { v[bj][n] = acc[ai][bj][m][n] * rs; const f32x4 x = v[bj][n]; ss += (x[0] * x[0] + x[1] * x[1]) + (x[2] * x[2] + x[3] * x[3]); }
                    ss += __shfl_xor(ss, 16); ss += __shfl_xor(ss, 32);
                    const float r2 = norm ? __builtin_amdgcn_rsqf(ss * (1.f / 64.f) + EPS) : 1.f;
#pragma unroll
                    for (int bj = 0; bj < 2; ++bj) { const f32x4 v0 = v[bj][0] * gv[bj][0] * r2, v1 = v[bj][1] * gv[bj][1] * r2;
                        if (k8) { u32x2 w8; w8.x = pk4_fp8(v0[0], v0[1], v0[2], v0[3]); w8.y = pk4_fp8(v1[0], v1[1], v1[2], v1[3]);
                            *(u32x2*)((unsigned char*)dst8 + (size_t)row * 128 + 32 * bj + 8 * fq) = w8; }
                        else { u32x4 w; w.x = pk2(v0[0], v0[1]); w.y = pk2(v0[2], v0[3]); w.z = pk2(v1[0], v1[1]); w.w = pk2(v1[2], v1[3]);
                            *(u32x4*)(dst + (size_t)row * ld + 32 * bj + 8 * fq) = w; } } }
        } else {
            if (wc == 0 && fq < 3) { float* gates = (float*)(ws + WS_GATES);
#pragma unroll
                for (int ai = 0; ai < 2; ++ai)
#pragma unroll
                    for (int m = 0; m < 4; ++m) { const int row = row0 + ai * 128 + m * 16; const float rs = rs_x[row];
#pragma unroll
                        for (int n = 0; n < 2; ++n) { const f32x4 x = acc[ai][0][m][n] * rs; f32x4 o; o[0] = sigmoidf_(x[0]); o[1] = sigmoidf_(x[1]); o[2] = sigmoidf_(x[2]); o[3] = sigmoidf_(x[3]);
                            *(f32x4*)(gates + (size_t)row * 24 + 8 * fq + 4 * n) = o; } }
            }
        }
    }
};

struct SchedCmp {
    static constexpr bool GATHER = false;
    int G, c; const char* kc; const char* vc; const char* w1;
    __device__ __forceinline__ bool next(int i, Unit& u) const { const int L = i * G + c; if (L >= 64) return false; u.aux = L >> 4; u.pm = L & 15; u.pn = 0; return true; }
    __device__ __forceinline__ const char* a_base(const Unit& u) const { return ((u.aux >> 1) ? vc : kc) + (u.aux & 1) * 128 + (size_t)u.pm * 256 * 4096; }
    __device__ __forceinline__ const char* b_base(const Unit& u) const { return w1 + (size_t)(u.aux >> 1) * (256 * 2048 * 2); }
};
struct EpiCmp1 {
    static constexpr bool PERM = true, MIDK = false;
    bf16* hid; const float* b1p;
    __device__ __forceinline__ void operator()(const f32x4 (&acc)[2][2][4][2], const Unit& u, int wr, int wc, int fr, int fq) const {
        const int kv = u.aux >> 1; const int row0 = u.pm * 256 + wr * 64 + fr, col0 = wc * 32 + 8 * fq;
        f32x4 bv[2][2];
#pragma unroll
        for (int bj = 0; bj < 2; ++bj)
#pragma unroll
            for (int n = 0; n < 2; ++n) { f32x4 s = {0.f, 0.f, 0.f, 0.f};
                for (int pp = 0; pp < 16; ++pp) s += *(const f32x4*)(b1p + (size_t)pp * 512 + kv * 256 + col0 + bj * 128 + 4 * n);
                bv[bj][n] = s; }
        bf16* O = hid + (size_t)u.aux * (4096 * 256);
#pragma unroll
        for (int ai = 0; ai < 2; ++ai)
#pragma unroll
            for (int m = 0; m < 4; ++m) { bf16* rowp = O + (size_t)(row0 + ai * 128 + m * 16) * 256 + col0;
#pragma unroll
                for (int bj = 0; bj < 2; ++bj) { f32x4 v0 = acc[ai][bj][m][0] + bv[bj][0], v1 = acc[ai][bj][m][1] + bv[bj][1];
#pragma unroll
                    for (int j = 0; j < 4; ++j) { v0[j] = gelu_tanh(v0[j]); v1[j] = gelu_tanh(v1[j]); }
                    u32x4 w; w.x = pk2(v0[0], v0[1]); w.y = pk2(v0[2], v0[3]); w.z = pk2(v1[0], v1[1]); w.w = pk2(v1[2], v1[3]);
                    *(u32x4*)(rowp + bj * 128) = w; } }
    }
};

struct EpiRes {
    static constexpr bool PERM = true, MIDK = false;
    const bf16* R; bf16* O; float* ssq; unsigned char* O8; float ascale;
    __device__ __forceinline__ void operator()(const f32x4 (&acc)[2][2][4][2], const Unit& u, int wr, int wc, int fr, int fq) const {
        const int row0 = u.pm * 256 + wr * 64 + fr, col0 = u.pn * 256 + wc * 32 + 8 * fq;
#pragma unroll
        for (int ai = 0; ai < 2; ++ai)
#pragma unroll
            for (int m = 0; m < 4; ++m) { const int row = row0 + ai * 128 + m * 16; const size_t off = (size_t)row * 1024 + col0; float ss = 0.f;
#pragma unroll
                for (int bj = 0; bj < 2; ++bj) { const u32x4 rv = *(const u32x4*)(R + off + bj * 128); f32x4 v0 = acc[ai][bj][m][0] * ascale, v1 = acc[ai][bj][m][1] * ascale;
                    v0[0] += bf2f(rv.x & 0xffffu); v0[1] += bf2f(rv.x >> 16); v0[2] += bf2f(rv.y & 0xffffu); v0[3] += bf2f(rv.y >> 16);
                    v1[0] += bf2f(rv.z & 0xffffu); v1[1] += bf2f(rv.z >> 16); v1[2] += bf2f(rv.w & 0xffffu); v1[3] += bf2f(rv.w >> 16);
                    ss += (v0[0] * v0[0] + v0[1] * v0[1]) + (v0[2] * v0[2] + v0[3] * v0[3]) + (v1[0] * v1[0] + v1[1] * v1[1]) + (v1[2] * v1[2] + v1[3] * v1[3]);
                    u32x4 w; w.x = pk2(v0[0], v0[1]); w.y = pk2(v0[2], v0[3]); w.z = pk2(v1[0], v1[1]); w.w = pk2(v1[2], v1[3]);
                    *(u32x4*)(O + off + bj * 128) = w;
                    if (O8) { u32x2 w8; w8.x = pk4_fp8(v0[0], v0[1], v0[2], v0[3]); w8.y = pk4_fp8(v1[0], v1[1], v1[2], v1[3]); *(u32x2*)(O8 + off + bj * 128) = w8; } }
                if (ssq) { ss += __shfl_xor(ss, 16); ss += __shfl_xor(ss, 32); if (fq == 0) ssq[(size_t)row * 16 + u.pn * 4 + wc] = ss; } }
    }
};

struct MoeInfo { int nt0, nt1; int pad[2]; int tile_exp[2 * MOE_MAXT]; };
template <bool GATH> struct SchedMoeT {
    static constexpr bool GATHER = GATH;
    int G, c, lo, cnt; const int* tile_exp; const char* A; const char* B; size_t tA, tB; const unsigned* aoff;
    __device__ __forceinline__ bool next(int i, Unit& u) const { const int L = i * G + c; if (L >= cnt * 4) return false; const int rt = lo + (L >> 2); const int e = tile_exp[rt]; u.pm = rt; u.pn = e * 4 + (L & 3); u.aux = 0; return true; }
    __device__ __forceinline__ const char* a_base(const Unit& u) const { return GATH ? A : A + (size_t)u.pm * tA; }
    __device__ __forceinline__ const char* b_base(const Unit& u) const { return B + (size_t)u.pn * tB; }
    __device__ __forceinline__ unsigned row_off(const Unit& u, int r) const { return aoff[u.pm * 256 + r]; }
};
struct EpiMoe1 {
    static constexpr bool PERM = true, MIDK = false;
    unsigned char* H; const float* wslot; const float* rsrow;
    __device__ __forceinline__ void operator()(const f32x4 (&acc)[2][2][4][2], const Unit& u, int wr, int wc, int fr, int fq) const {
        const int row0 = u.pm * 256 + wr * 64 + fr, col0 = (u.pn & 3) * 128 + wc * 32 + 8 * fq;
#pragma unroll
        for (int ai = 0; ai < 2; ++ai)
#pragma unroll
            for (int m = 0; m < 4; ++m) { const int row = row0 + ai * 128 + m * 16; const float w = wslot[row] * F8_H_SCALE, rs = rsrow[row] * (1.f / F8_W13_SCALE);
                f32x4 o[2];
#pragma unroll
                for (int n = 0; n < 2; ++n)
#pragma unroll
                    for (int j = 0; j < 4; ++j) o[n][j] = silu_(acc[ai][0][m][n][j] * rs) * (acc[ai][1][m][n][j] * rs) * w;
                if (MOE_FP8) { u32x2 pw; pw.x = pk4_fp8(o[0][0], o[0][1], o[0][2], o[0][3]); pw.y = pk4_fp8(o[1][0], o[1][1], o[1][2], o[1][3]); *(u32x2*)(H + (size_t)row * 512 + col0) = pw; }
                else { u32x4 pw; pw.x = pk2(o[0][0], o[0][1]); pw.y = pk2(o[0][2], o[0][3]); pw.z = pk2(o[1][0], o[1][1]); pw.w = pk2(o[1][2], o[1][3]); *(u32x4*)((bf16*)H + (size_t)row * 512 + col0) = pw; } }
    }
};
struct EpiY {
    static constexpr bool PERM = true, MIDK = false;
    bf16* Y; float scale;
    __device__ __forceinline__ void operator()(const f32x4 (&acc)[2][2][4][2], const Unit& u, int wr, int wc, int fr, int fq) const {
        const int row0 = u.pm * 256 + wr * 64 + fr, col0 = (u.pn & 3) * 256 + wc * 32 + 8 * fq;
#pragma unroll
        for (int ai = 0; ai < 2; ++ai)
#pragma unroll
            for (int m = 0; m < 4; ++m) { bf16* rowp = Y + (size_t)(row0 + ai * 128 + m * 16) * 1024 + col0;
#pragma unroll
                for (int bj = 0; bj < 2; ++bj) { const f32x4 v0 = acc[ai][bj][m][0] * scale, v1 = acc[ai][bj][m][1] * scale;
                    u32x4 w; w.x = pk2(v0[0], v0[1]); w.y = pk2(v0[2], v0[3]); w.z = pk2(v1[0], v1[1]); w.w = pk2(v1[2], v1[3]);
                    *(u32x4*)(rowp + bj * 128) = w; } }
    }
};
template <int PASS> struct EpiMoe2 {
    static constexpr bool PERM = true, MIDK = false;
    const int* tokmap; const bf16* Rin; bf16* P0; float* out;
    __device__ __forceinline__ void operator()(const f32x4 (&acc)[2][2][4][2], const Unit& u, int wr, int wc, int fr, int fq) const {
        const int row0 = u.pm * 256 + wr * 64 + fr, col0 = (u.pn & 3) * 256 + wc * 32 + 8 * fq;
        int tk[2][4];
#pragma unroll
        for (int ai = 0; ai < 2; ++ai)
#pragma unroll
            for (int m = 0; m < 4; ++m) tk[ai][m] = tokmap[row0 + ai * 128 + m * 16];
#pragma unroll
        for (int ai = 0; ai < 2; ++ai) {
            u32x4 rv[4][2];
#pragma unroll
            for (int m = 0; m < 4; ++m) { const size_t off = (size_t)max(tk[ai][m], 0) * 1024 + col0;
#pragma unroll
                for (int bj = 0; bj < 2; ++bj) rv[m][bj] = *(const u32x4*)(Rin + off + bj * 128); }
#pragma unroll
            for (int m = 0; m < 4; ++m) { const int tok = tk[ai][m]; const size_t off = (size_t)max(tok, 0) * 1024 + col0;
#pragma unroll
                for (int bj = 0; bj < 2; ++bj) { const u32x4 r = rv[m][bj]; f32x4 v0 = acc[ai][bj][m][0] * (1.f / (F8_H_SCALE * F8_W2_SCALE)), v1 = acc[ai][bj][m][1] * (1.f / (F8_H_SCALE * F8_W2_SCALE));
                    v0[0] += bf2f(r.x & 0xffffu); v0[1] += bf2f(r.x >> 16); v0[2] += bf2f(r.y & 0xffffu); v0[3] += bf2f(r.y >> 16);
                    v1[0] += bf2f(r.z & 0xffffu); v1[1] += bf2f(r.z >> 16); v1[2] += bf2f(r.w & 0xffffu); v1[3] += bf2f(r.w >> 16);
                    if (tok >= 0) {
                        if (PASS == 0) { u32x4 w; w.x = pk2(v0[0], v0[1]); w.y = pk2(v0[2], v0[3]); w.z = pk2(v1[0], v1[1]); w.w = pk2(v1[2], v1[3]); *(u32x4*)(P0 + off + bj * 128) = w; }
                        else { *(f32x4*)(out + off + bj * 128) = v0; *(f32x4*)(out + off + bj * 128 + 4) = v1; } } } }
        }
    }
};
typedef float f32x2v __attribute__((ext_vector_type(2)));
struct EpiOutMid {
    static constexpr bool PERM = true, MIDK = true;
    const bf16* R; bf16* O; float* ssq; const float* sq_rg; const float* sq_nsa; unsigned char* O8;
    __device__ __forceinline__ void unit_begin(const Unit& u, int ui, PG8_LAS unsigned char* lds, int tid) const {
        if (tid < 256) { const int row = u.pm * 256 + tid;
            const f32x4 a = *(const f32x4*)(sq_rg + (size_t)row * 8), b = *(const f32x4*)(sq_rg + (size_t)row * 8 + 4), c = *(const f32x4*)(sq_nsa + (size_t)row * 8), d = *(const f32x4*)(sq_nsa + (size_t)row * 8 + 4);
            const float r1 = __builtin_amdgcn_rsqf((((a.x + a.y) + (a.z + a.w)) + ((b.x + b.y) + (b.z + b.w))) * (1.f / 512.f) + EPS);
            const float r2 = __builtin_amdgcn_rsqf((((c.x + c.y) + (c.z + c.w)) + ((d.x + d.y) + (d.z + d.w))) * (1.f / 512.f) + EPS);
            f32x2v o; o.x = r1 / r2; o.y = r2; ((PG8_LAS f32x2v*)(lds + pg8::STAGE_BYTES))[(ui & 1) * 256 + tid] = o; }
    }
    __device__ __forceinline__ void midk(f32x4 (&acc)[2][2][4][2], const Unit& u, int ui, PG8_LAS unsigned char* lds, int wr, int wc, int fr, int fq) const {
        const PG8_LAS f32x2v* tab = (const PG8_LAS f32x2v*)(lds + pg8::STAGE_BYTES) + (ui & 1) * 256 + wr * 64 + fr;
#pragma unroll
        for (int ai = 0; ai < 2; ++ai)
#pragma unroll
            for (int m = 0; m < 4; ++m) { const float f = tab[ai * 128 + m * 16].x;
#pragma unroll
                for (int bj = 0; bj < 2; ++bj)
#pragma unroll
                    for (int n = 0; n < 2; ++n) acc[ai][bj][m][n] *= f; }
    }
    __device__ __forceinline__ void fin(const f32x4 (&acc)[2][2][4][2], const Unit& u, int ui, PG8_LAS unsigned char* lds, int wr, int wc, int fr, int fq) const {
        const PG8_LAS f32x2v* tab = (const PG8_LAS f32x2v*)(lds + pg8::STAGE_BYTES) + (ui & 1) * 256 + wr * 64 + fr;
        const int row0 = u.pm * 256 + wr * 64 + fr, col0 = u.pn * 256 + wc * 32 + 8 * fq;
#pragma unroll
        for (int ai = 0; ai < 2; ++ai) {
            u32x4 rva[4][2];
#pragma unroll
            for (int m = 0; m < 4; ++m)
#pragma unroll
                for (int bj = 0; bj < 2; ++bj) rva[m][bj] = *(const u32x4*)(R + (size_t)(row0 + ai * 128 + m * 16) * 1024 + col0 + bj * 128);
            asm volatile("" : "+v"(rva[0][0]), "+v"(rva[0][1]), "+v"(rva[1][0]), "+v"(rva[1][1]), "+v"(rva[2][0]), "+v"(rva[2][1]), "+v"(rva[3][0]), "+v"(rva[3][1]));
#pragma unroll
            for (int m = 0; m < 4; ++m) { const int row = row0 + ai * 128 + m * 16; const size_t off = (size_t)row * 1024 + col0; float ss = 0.f; const float f = tab[ai * 128 + m * 16].y * (WOUT_FP8 ? 1.f / (F8_MIX_SCALE * F8_WOUT_SCALE) : 1.f);
#pragma unroll
                for (int bj = 0; bj < 2; ++bj) { const u32x4 rv = rva[m][bj]; f32x4 v0 = acc[ai][bj][m][0] * f, v1 = acc[ai][bj][m][1] * f;
                    v0[0] += bf2f(rv.x & 0xffffu); v0[1] += bf2f(rv.x >> 16); v0[2] += bf2f(rv.y & 0xffffu); v0[3] += bf2f(rv.y >> 16);
                    v1[0] += bf2f(rv.z & 0xffffu); v1[1] += bf2f(rv.z >> 16); v1[2] += bf2f(rv.w & 0xffffu); v1[3] += bf2f(rv.w >> 16);
                    ss += (v0[0] * v0[0] + v0[1] * v0[1]) + (v0[2] * v0[2] + v0[3] * v0[3]) + (v1[0] * v1[0] + v1[1] * v1[1]) + (v1[2] * v1[2] + v1[3] * v1[3]);
                    u32x4 w; w.x = pk2(v0[0], v0[1]); w.y = pk2(v0[2], v0[3]); w.z = pk2(v1[0], v1[1]); w.w = pk2(v1[2], v1[3]);
                    *(u32x4*)(O + off + bj * 128) = w;
                    if (O8) { u32x2 w8; w8.x = pk4_fp8(v0[0], v0[1], v0[2], v0[3]); w8.y = pk4_fp8(v1[0], v1[1], v1[2], v1[3]); *(u32x2*)(O8 + off + bj * 128) = w8; } }
                ss += __shfl_xor(ss, 16); ss += __shfl_xor(ss, 32); if (fq == 0) ssq[(size_t)row * 16 + u.pn * 4 + wc] = ss; } }
    }
    __device__ __forceinline__ void operator()(const f32x4 (&acc)[2][2][4][2], const Unit& u, int wr, int wc, int fr, int fq) const {}
};
struct Args { const float* in[40]; float* out; unsigned char* ws; int lo, hi; };
typedef const float* fptr_t;
typedef const __attribute__((address_space(4))) fptr_t* intab_t;
struct Ctx {
    intab_t in; float* out; unsigned char* ws; LAS unsigned char* lds; int tid, lane, wave, G, bid;
};

#ifndef TR_NT
#define TR_NT 1
#endif
__device__ __forceinline__ void tr_item(const float* W, int ldw, int c0, int cvalid, const float* gain, bf16* WT, int K, int r0, int k0, LAS float* scr, int lane) {
    const int cc = c0 + (lane & 31); const bool ok = cc < cvalid;
    float v[32];
#pragma unroll
    for (int i = 0; i < 32; ++i) { const int kk = 2 * i + (lane >> 5); v[i] = ok ? (TR_NT ? __builtin_nontemporal_load(W + (size_t)(k0 + kk) * ldw + cc) : W[(size_t)(k0 + kk) * ldw + cc]) : 0.f; }
    if (gain) { float gq[32];
#pragma unroll
        for (int i = 0; i < 32; ++i) gq[i] = gain[k0 + 2 * i + (lane >> 5)];
#pragma unroll
        for (int i = 0; i < 32; ++i) v[i] *= gq[i]; }
#pragma unroll
    for (int i = 0; i < 32; ++i) { const int kk = 2 * i + (lane >> 5); scr[kk * 33 + (lane & 31)] = v[i]; }
    asm volatile("s_waitcnt lgkmcnt(0)" ::: "memory");
    const int c = lane & 7;
#pragma unroll
    for (int j = 0; j < 4; ++j) { const int n = (lane >> 3) + 8 * j; const LAS float* s = scr + (8 * c) * 33 + n;
        u32x4 o; o.x = pk2(s[0 * 33], s[1 * 33]); o.y = pk2(s[2 * 33], s[3 * 33]); o.z = pk2(s[4 * 33], s[5 * 33]); o.w = pk2(s[6 * 33], s[7 * 33]);
        *(u32x4*)(WT + (size_t)(r0 + n) * K + k0 + 8 * c) = o; }
    asm volatile("s_waitcnt lgkmcnt(0)" ::: "memory");
}
__device__ __forceinline__ void tr_item8(const float* W, int ldw, int c0, const float* gain, float scale, unsigned char* WT8, int K, int r0, int k0, LAS float* scr, int lane) {
    const int cc = c0 + (lane & 31);
    float v[32];
#pragma unroll
    for (int i = 0; i < 32; ++i) { const int kk = 2 * i + (lane >> 5); v[i] = TR_NT ? __builtin_nontemporal_load(W + (size_t)(k0 + kk) * ldw + cc) : W[(size_t)(k0 + kk) * ldw + cc]; }
    if (gain) { float gq[32];
#pragma unroll
        for (int i = 0; i < 32; ++i) gq[i] = gain[k0 + 2 * i + (lane >> 5)];
#pragma unroll
        for (int i = 0; i < 32; ++i) v[i] *= gq[i]; }
#pragma unroll
    for (int i = 0; i < 32; ++i) { const int kk = 2 * i + (lane >> 5); scr[kk * 33 + (lane & 31)] = v[i] * scale; }
    asm volatile("s_waitcnt lgkmcnt(0)" ::: "memory");
    const int c = lane & 7;
#pragma unroll
    for (int j = 0; j < 4; ++j) { const int n = (lane >> 3) + 8 * j; const LAS float* s = scr + (8 * c) * 33 + n;
        u32x2 o; o.x = pk4_fp8(s[0 * 33], s[1 * 33], s[2 * 33], s[3 * 33]); o.y = pk4_fp8(s[4 * 33], s[5 * 33], s[6 * 33], s[7 * 33]);
        *(u32x2*)(WT8 + (size_t)(r0 + n) * K + k0 + 8 * c) = o; }
    asm volatile("s_waitcnt lgkmcnt(0)" ::: "memory");
}
__device__ __forceinline__ int inproj_src_col(int n0) {
    const int pn = n0 >> 8, cl = n0 & 255, bj = cl >> 7, wc = (cl & 127) >> 5;
    if (pn < 4) return n0;
    if (pn < 6) return 1024 + (4 * (pn - 4) + wc) * 64 + 32 * bj;
    if (pn < 9) { const int base = 1536 + (pn - 6) * 256; return (wc < 2) ? base + wc * 64 + 32 * bj : base + 128 + (wc - 2) * 64 + 32 * bj; }
    return (cl < 32) ? 2304 : 100000;
}
__device__ __forceinline__ void phase_expert_weights(const Ctx& C, int gw, int NGW) {
    LAS float* scr = (LAS float*)(C.lds + C.wave * 16384);
    const intab_t in = C.in; unsigned char* ws = C.ws;
    constexpr int I_13 = 32 * 16, I_2 = 32 * 8;
    for (int it = gw; it < 32 * I_13 + 32 * I_2; it += NGW) {
        int r = it;
        if (r < 32 * I_13) { const int e = r / I_13, rr = r % I_13, nb = rr / 16, kb = rr % 16;
            const int p = nb >> 3, cl = (nb & 7) * 32; const bool is3 = cl >= 128; const int sc = 128 * p + (cl & 127);
            if (MOE_FP8) tr_item8(in[is3 ? 38 : 37] + (size_t)e * 1024 * 512, 512, sc, in[32], F8_W13_SCALE, ws + WS_W13 + (size_t)e * 1024 * 1024, 1024, nb * 32, kb * 64, scr, C.lane);
            else tr_item(in[is3 ? 38 : 37] + (size_t)e * 1024 * 512, 512, sc, 512, in[32], (bf16*)(ws + WS_W13) + (size_t)e * 1024 * 1024, 1024, nb * 32, kb * 64, scr, C.lane);
            continue; } r -= 32 * I_13;
        { const int e = r / I_2, rr = r % I_2, nb = rr / 8, kb = rr % 8;
            if (MOE_FP8) tr_item8(in[39] + (size_t)e * 512 * 1024, 1024, nb * 32, nullptr, F8_W2_SCALE, ws + WS_W2 + (size_t)e * 1024 * 512, 512, nb * 32, kb * 64, scr, C.lane);
            else tr_item(in[39] + (size_t)e * 512 * 1024, 1024, nb * 32, 1024, nullptr, (bf16*)(ws + WS_W2) + (size_t)e * 1024 * 512, 512, nb * 32, kb * 64, scr, C.lane); }
    }
}
struct EwSlab { const float* src; const float* gain; unsigned char* dst; int ld, k0, dstK; float scale; };
__device__ __forceinline__ EwSlab ew_slab(const Ctx& C, int s, int t, int& drow) {
    EwSlab d; const intab_t in = C.in;
    if (s < 1024) { const int e = s >> 5, m = (s >> 4) & 1, kb = s & 15;
        d.src = in[37 + m] + (size_t)e * 1024 * 512 + (size_t)kb * 64 * 512; d.ld = 512; d.gain = in[32]; d.scale = F8_W13_SCALE; d.k0 = kb * 64; d.dstK = 1024;
        d.dst = C.ws + WS_W13 + (size_t)e * 1024 * 1024; drow = 256 * (t >> 7) + 128 * m + (t & 127); }
    else { const int s2 = s - 1024, e = s2 >> 4, kb = (s2 >> 1) & 7, c2 = s2 & 1;
        d.src = in[39] + (size_t)e * 512 * 1024 + (size_t)kb * 64 * 1024 + 512 * c2; d.ld = 1024; d.gain = nullptr; d.scale = F8_W2_SCALE; d.k0 = kb * 64; d.dstK = 512;
        d.dst = C.ws + WS_W2 + (size_t)e * 1024 * 512; drow = 512 * c2 + t; }
    return d; }
__device__ __forceinline__ void phase_expert_weights_wg(const Ctx& C, int wg, int nwg, int s_end = 1536) {
    static_assert(MOE_FP8 != 0, "fp8 expert weights");
    LAS float* tile = (LAS float*)C.lds;
    LAS float* gl = (LAS float*)(C.lds + 131072);
    for (int i = C.tid; i < 1024 + 64; i += 512) gl[i] = (i < 1024) ? C.in[32][i] : 1.f;
    const int t = C.tid;
    int s = wg; if (s >= s_end) return;
    f32x4 pa[16], pb[16]; int drow = 0, drow_a = 0, drow_b = 0;
    EwSlab cur, sa, sb;
#ifndef SLAB_NT
#define SLAB_NT 1
#endif
#define EW_LD(D, P, S, DR) do { D = ew_slab(C, (S), t, DR); _Pragma("unroll") for (int j = 0; j < 16; ++j) { const int q = t + 512 * j; P[j] = SLAB_NT ? __builtin_nontemporal_load((const f32x4*)(D.src + (size_t)(q >> 7) * D.ld + (q & 127) * 4)) : *(const f32x4*)(D.src + (size_t)(q >> 7) * D.ld + (q & 127) * 4); } } while (0)
#define EW_PUT(P) do { _Pragma("unroll") for (int j = 0; j < 16; ++j) *(LAS f32x4*)(tile + (t + 512 * j) * 4) = P[j]; } while (0)
#define EW_OUT() do { unsigned char* drp = cur.dst + (size_t)drow * cur.dstK + cur.k0; const int gbase = cur.gain ? cur.k0 : 1024; \
        _Pragma("unroll") for (int g = 0; g < 4; ++g) { float v[16]; \
            _Pragma("unroll") for (int k = 0; k < 16; ++k) v[k] = tile[(16 * g + k) * 512 + t] * cur.scale * gl[gbase + 16 * g + k]; \
            u32x4 o; o.x = pk4_fp8(v[0], v[1], v[2], v[3]); o.y = pk4_fp8(v[4], v[5], v[6], v[7]); o.z = pk4_fp8(v[8], v[9], v[10], v[11]); o.w = pk4_fp8(v[12], v[13], v[14], v[15]); \
            *(u32x4*)(drp + 16 * g) = o; } } while (0)
    EW_LD(sa, pa, s, drow_a); sb = sa;
    const bool hb0 = s + nwg < s_end; if (hb0) EW_LD(sb, pb, s + nwg, drow_b);
    for (;;) {
        __syncthreads(); EW_PUT(pa); cur = sa; drow = drow_a;
        const bool h2 = s + 2 * nwg < s_end; if (h2) EW_LD(sa, pa, s + 2 * nwg, drow_a);
        __syncthreads(); EW_OUT();
        if (s + nwg >= s_end) break;
        __syncthreads(); EW_PUT(pb); cur = sb; drow = drow_b;
        const bool h3 = s + 3 * nwg < s_end; if (h3) EW_LD(sb, pb, s + 3 * nwg, drow_b);
        __syncthreads(); EW_OUT();
        if (!h2) break;
        s += 2 * nwg;
    }
    __syncthreads();
#undef EW_LD
#undef EW_PUT
#undef EW_OUT
}
__device__ __forceinline__ void phase_prologue(const Ctx& C) {
    LAS float* scr = (LAS float*)(C.lds + C.wave * 16384);
    const int gw = C.bid * 8 + C.wave, NGW = C.G * 8;
    const intab_t in = C.in; unsigned char* ws = C.ws;
    constexpr int I_WIN = 80 * 16, I_SQ = 32 * 16, I_KV = 64 * 16, I_CW = 8 * 32;
    constexpr int NIT = I_WIN + 3 * I_SQ + I_KV + 2 * I_CW;
    for (int it = gw; it < NIT; it += NGW) {
        int r = it;
        if (r < I_WIN) { const int nb = r / 16, kb = r % 16; tr_item(in[4], NPROJ, inproj_src_col(nb * 32), NPROJ, in[3], (bf16*)(ws + WS_WIN), 1024, nb * 32, kb * 64, scr, C.lane); continue; } r -= I_WIN;
        if (r < I_SQ) { const int nb = r / 16, kb = r % 16; if (WOUT_FP8) tr_item8(in[24], 1024, nb * 32, kb < 8 ? in[22] : in[23] - 512, F8_WOUT_SCALE, ws + WS_WOUT, 1024, nb * 32, kb * 64, scr, C.lane); else tr_item(in[24], 1024, nb * 32, 1024, kb < 8 ? in[22] : in[23] - 512, (bf16*)(ws + WS_WOUT), 1024, nb * 32, kb * 64, scr, C.lane); continue; } r -= I_SQ;
        if (r < I_SQ) { const int nb = r / 16, kb = r % 16; if (XQ_FP8) tr_item8(in[27], 1024, nb * 32, in[25], F8_WQ_SCALE, ws + WS_WQ, 1024, nb * 32, kb * 64, scr, C.lane); else tr_item(in[27], 1024, nb * 32, 1024, in[25], (bf16*)(ws + WS_WQ), 1024, nb * 32, kb * 64, scr, C.lane); continue; } r -= I_SQ;
        if (r < I_SQ) { const int nb = r / 16, kb = r % 16; if (XO_FP8) tr_item8(in[29], 1024, nb * 32, nullptr, F8_WO_SCALE, ws + WS_WO, 1024, nb * 32, kb * 64, scr, C.lane); else tr_item(in[29], 1024, nb * 32, 1024, nullptr, (bf16*)(ws + WS_WO), 1024, nb * 32, kb * 64, scr, C.lane); continue; } r -= I_SQ;
        if (r < I_KV) { const int nb = r / 16, kb = r % 16; if (XKV_FP8) tr_item8(in[28], 2048, nb * 32, nullptr, F8_WKV_SCALE, ws + WS_WKV, 1024, nb * 32, kb * 64, scr, C.lane); else tr_item(in[28], 2048, nb * 32, 2048, nullptr, (bf16*)(ws + WS_WKV), 1024, nb * 32, kb * 64, scr, C.lane); continue; } r -= I_KV;
        { const int kv = r / I_CW, rr = r % I_CW, nb = rr / 32, kb = rr % 32; tr_item(in[kv ? 20 : 18], 256, nb * 32, 256, nullptr, (bf16*)(ws + WS_CW1) + (size_t)kv * 256 * 2048, 2048, nb * 32, kb * 64, scr, C.lane); }
    }
    {
        float* rsx = (float*)(ws + WS_RSX); bf16* xb = (bf16*)(ws + WS_A); bf16* mnb = (bf16*)(ws + WS_MNB);
        for (int m0 = 4 * gw; m0 < T + TM; m0 += 4 * NGW) {
            f32x4 v[4][4]; float s[4];
#pragma unroll
            for (int q = 0; q < 4; ++q) { const int m = m0 + q; const float* src = (m < T) ? in[0] + (size_t)m * 1024 : in[1] + (size_t)(m - T) * 1024; const f32x4* xr = (const f32x4*)src + C.lane;
#pragma unroll
#ifndef P0_NT
#define P0_NT 1
#endif
                for (int j = 0; j < 4; ++j) v[q][j] = P0_NT ? __builtin_nontemporal_load(xr + 64 * j) : xr[64 * j]; }
#pragma unroll
            for (int q = 0; q < 4; ++q) { float a = 0.f;
#pragma unroll
                for (int j = 0; j < 4; ++j) a += (v[q][j].x * v[q][j].x + v[q][j].y * v[q][j].y) + (v[q][j].z * v[q][j].z + v[q][j].w * v[q][j].w);
                s[q] = a; }
#pragma unroll
            for (int q = 0; q < 4; ++q) { const int m = m0 + q; const bool isx = m < T;
                const float rs = __builtin_amdgcn_rsqf(wave_sum(s[q]) * (1.f / 1024.f) + EPS);
                if (isx) { if (C.lane == 0) rsx[m] = rs;
                    unsigned long long* o8 = (unsigned long long*)(xb + (size_t)m * 1024) + C.lane;
#pragma unroll
                    for (int j = 0; j < 4; ++j) o8[64 * j] = (unsigned long long)pk2(v[q][j].x, v[q][j].y) | ((unsigned long long)pk2(v[q][j].z, v[q][j].w) << 32);
                } else { const f32x4* gr = (const f32x4*)in[26] + C.lane;
                    unsigned long long* o8 = (unsigned long long*)(mnb + (size_t)(m - T) * 1024) + C.lane;
#pragma unroll
                    for (int j = 0; j < 4; ++j) { const f32x4 g = gr[64 * j];
                        if (XKV_FP8) ((unsigned*)((unsigned char*)mnb + (size_t)(m - T) * 1024))[C.lane + 64 * j] = pk4_fp8(v[q][j].x * rs * g.x, v[q][j].y * rs * g.y, v[q][j].z * rs * g.z, v[q][j].w * rs * g.w);
                        else o8[64 * j] = (unsigned long long)pk2(v[q][j].x * rs * g.x, v[q][j].y * rs * g.y) | ((unsigned long long)pk2(v[q][j].z * rs * g.z, v[q][j].w * rs * g.w) << 32); }
                } }
        }
    }
    const int gt = C.bid * 512 + C.tid, NGT = C.G * 512;
    { float* b2 = (float*)(ws + WS_BIAS2);
        for (int i = gt; i < 8 * 132; i += NGT) { const int h = i / 132, d = i % 132; const int bk = d < 128 ? kBucket[d] : 31; b2[i] = in[2][bk * 8 + h] * LOG2E; } }
    { float* bp = (float*)(ws + WS_CB1P);
        for (int idx = gt; idx < 16 * 512 * 16; idx += NGT) { const int i = idx >> 4, sl = idx & 15, pp = i / 512, kv = (i % 512) / 256, n = i % 256; const float* pos = in[kv ? 17 : 16]; const float* w1 = in[kv ? 20 : 18];
            float sm = 0.f; const int k0 = pp * 128 + sl * 8;
#pragma unroll
            for (int k = 0; k < 8; ++k) sm += pos[k0 + k] * w1[(size_t)(k0 + k) * 256 + n];
            sm += __shfl_xor(sm, 1); sm += __shfl_xor(sm, 2); sm += __shfl_xor(sm, 4); sm += __shfl_xor(sm, 8);
            if (sl == 0) bp[i] = sm; } }
    { bf16* wr = (bf16*)(ws + WS_WR);
        for (int i = gt; i < 36 * 1024; i += NGT) { const int n = i / 1024, k = i % 1024; float v = (n < 4) ? in[33][k * 4 + n] : in[35][k * 32 + (n - 4)];
            v *= in[32][k]; const unsigned hi = f2bf(v); const float rem = v - bf2f(hi);
            const int half = k >> 9, kl = k & 511, g6 = kl >> 6, hh = (kl >> 5) & 1, u = (kl >> 3) & 3, j = kl & 7, sl = 4 * g6 + u;
            const int e = (n < 32) ? ((sl * 2 + hh) * 32 + n) * 8 + j : 32768 + ((sl * 2 + hh) * 4 + (n - 32)) * 8 + j;
            wr[half * 36864 + e] = (bf16)hi; wr[half * 36864 + e + ((n < 32) ? 16384 : 2048)] = (bf16)f2bf(rem); } }
    { bf16* rw = (bf16*)(ws + WS_RGW);
        for (int i = gt; i < 65536; i += NGT) { const int j = i & 7, ln = (i >> 3) & 63, nb = (i >> 9) & 1, sq = (i >> 10) & 3, ri = (i >> 12) & 1, wv = i >> 13;
            const int k = 16 * sq + 8 * (ln >> 5) + j; rw[i] = (bf16)f2bf(-LOG2E * in[ri ? 9 : 7][wv * 4096 + k * 64 + 32 * nb + (ln & 31)]); } }
    { float* gt2 = (float*)(ws + WS_GTAB); for (int i = gt; i < 192; i += NGT) { const int k = i / 64, d = i % 64; gt2[i] = (k == 0) ? in[12][d] * QSCALE : (k == 1 ? in[14][d] : in[15][d]); } }
    { int* tm = (int*)(ws + WS_TOKMAP); float* wsl = (float*)(ws + WS_WSLOT);
        unsigned* ao = (unsigned*)(ws + WS_AOFF); float* rr = (float*)(ws + WS_RSROW);
        for (int i = gt; i < MOE_ROWS; i += NGT) { tm[i] = -1; wsl[i] = 0.f; ao[i] = 0u; rr[i] = 0.f; } }
}

__device__ __forceinline__ void pass_knorm(const Ctx& C) {
    bf16* kvx = (bf16*)(C.ws + WS_KVX); const float* gk = C.in[31];
    const int gw = C.bid * 8 + C.wave, NGW = C.G * 8;
    const f32x4 g = *((const f32x4*)gk + C.lane) * *((const f32x4*)C.in[30] + C.lane);
    constexpr int NITEM = TM * 4; const int per = (NITEM + NGW - 1) / NGW, i0 = gw * per, i1 = (i0 + per < NITEM) ? i0 + per : NITEM;
    for (int it0 = i0; it0 < i1; it0 += 8) { unsigned long long wv[8];
#pragma unroll
        for (int q = 0; q < 8; ++q) { const int it = (it0 + q < i1) ? it0 + q : i1 - 1; wv[q] = *((const unsigned long long*)(kvx + (size_t)(it >> 2) * 2048 + (it & 3) * 256) + C.lane); }
#pragma unroll
        for (int q = 0; q < 8; ++q) { const int it = it0 + q; const unsigned long long w = wv[q];
            const float a = bf2f((unsigned)w & 0xffffu), b = bf2f(((unsigned)w) >> 16), c = bf2f((unsigned)(w >> 32) & 0xffffu), d = bf2f((unsigned)(w >> 48));
            const float rs = __builtin_amdgcn_rsqf(wave_sum(a * a + b * b + c * c + d * d) * (1.f / 256.f) + EPS);
            if (it < i1) ((unsigned*)(C.ws + WS_XK8 + (size_t)(it >> 2) * 1024 + (it & 3) * 256))[C.lane] = pk4_fp8(a * rs * g.x, b * rs * g.y, c * rs * g.z, d * rs * g.w); }
    }
}
__device__ __forceinline__ void pass_nsanorm(const Ctx& C) {
    bf16* mixed = (bf16*)(C.ws + WS_C);
    const int gw = C.bid * 8 + C.wave, NGW = C.G * 8;
    for (int row = gw; row < T; row += NGW) {
        u32x4* p = (u32x4*)(mixed + (size_t)row * 1024 + 512) + C.lane;
        const u32x4 w = *p; float v[8]; v[0] = bf2f(w.x & 0xffffu); v[1] = bf2f(w.x >> 16); v[2] = bf2f(w.y & 0xffffu); v[3] = bf2f(w.y >> 16); v[4] = bf2f(w.z & 0xffffu); v[5] = bf2f(w.z >> 16); v[6] = bf2f(w.w & 0xffffu); v[7] = bf2f(w.w >> 16);
        float s = 0.f;
#pragma unroll
        for (int j = 0; j < 8; ++j) s += v[j] * v[j];
        const float rs = __builtin_amdgcn_rsqf(wave_sum(s) * (1.f / 512.f) + EPS);
        u32x4 o; o.x = pk2(v[0] * rs, v[1] * rs); o.y = pk2(v[2] * rs, v[3] * rs); o.z = pk2(v[4] * rs, v[5] * rs); o.w = pk2(v[6] * rs, v[7] * rs);
        *p = o;
    }
}
__device__ __forceinline__ int crow(int r, int hi) { return (r & 3) + 8 * (r >> 2) + 4 * hi; }
#define CROW0(r) (((r) & 3) + 8 * ((r) >> 2))
constexpr int RG_CK = 32, RG_NCK = SEQ / RG_CK;
template <bool FINAL> __device__ __forceinline__ void phase_rg(const Ctx& C, int rA = -2, int rB = -1) {
    int lane_ = C.lane; asm volatile("" : "+v"(lane_));
    const int w = C.wave, lane = lane_, r32 = lane & 31, hh = lane >> 5, ch0 = 64 * w;
    const intab_t in = C.in;
    const bf16* U = (const bf16*)(C.ws + WS_U); const bf16* GT = (const bf16*)(C.ws + WS_GATE); bf16* mixed = (bf16*)(C.ws + WS_C);
    float* rgsum = (float*)(C.ws + WS_RGSUM);
    LAS unsigned char* Ub = C.lds + w * 19456; LAS unsigned char* UC = Ub + 10240; LAS unsigned char* Gt = UC + 4608;
    const unsigned ulds = (unsigned)(unsigned long)Ub;
    bf16x8 Br[4][2], Bi[4][2];
    { const char* rwu = (const char*)(C.ws + WS_RGW) + (size_t)w * 16384; const unsigned rwo = (unsigned)lane * 16u;
#pragma unroll
        for (int s = 0; s < 4; ++s)
#pragma unroll
            for (int nb = 0; nb < 2; ++nb) { Br[s][nb] = *(const bf16x8*)(rwu + (unsigned)((s * 2 + nb) * 1024) + rwo); Bi[s][nb] = *(const bf16x8*)(rwu + 8192u + (unsigned)((s * 2 + nb) * 1024) + rwo); } }
    float cbr[2], cbi[2], csp[2];
#pragma unroll
    for (int nb = 0; nb < 2; ++nb) { const int c = ch0 + 32 * nb + r32; cbr[nb] = -LOG2E * in[8][c]; cbi[nb] = -LOG2E * in[10][c]; csp[nb] = -8.f * LOG2E * log1pf(__expf(-in[11][c])); }
    const int ch8 = ch0 + (lane & 7) * 8;
#ifndef RG_REP
#define RG_REP 1
#endif
    constexpr int RUN = 8, NRUN = RG_NCK / RUN;
    for (int rep = 0; rep < RG_REP; ++rep)
    for (int rq = 0; rq < ((rA != -2) ? 2 : (NBATCH * NRUN - C.bid + C.G - 1) / C.G); ++rq) {
      const int rv = (rA != -2) ? (rq ? rB : rA) : C.bid + rq * C.G; if (rv < 0) continue;
      const int b = rv / NRUN, run = rv % NRUN;
      float h0[2] = {0.f, 0.f}, arun[2] = {1.f, 1.f};
      if (FINAL) {
          const char* spu = (const char*)((const float2*)rgsum + ((size_t)b * NRUN) * 512); unsigned spo = (unsigned)(ch0 + r32) * 8u; asm volatile("" : "+v"(spo)); float2 v[NRUN - 1][2];
#pragma unroll
          for (int u = 0; u < NRUN - 1; ++u) if (u < run) { v[u][0] = *(const float2*)(spu + (size_t)u * 4096 + spo); v[u][1] = *(const float2*)(spu + (size_t)u * 4096 + spo + 256); }
#pragma unroll
          for (int u = 0; u < NRUN - 1; ++u) if (u < run) { h0[0] = v[u][0].x * h0[0] + v[u][0].y; h0[1] = v[u][1].x * h0[1] + v[u][1].y; }
      }
      const char* ubu = (const char*)(U + ((size_t)b * SEQ + (size_t)run * RUN * RG_CK) * 512); int uof = ((lane >> 3) - 3) * 1024 + ch8 * 2; asm volatile("" : "+v"(uof));
#define RG_DMA(c, buf) do { _Pragma("unroll") for (int p = 0; p < 5; ++p) glds16(ubu + (size_t)(c) * (RG_CK * 1024) + p * 8192 + (long)uof, (unsigned)__builtin_amdgcn_readfirstlane(ulds + (buf) * 5120 + p * 1024)); } while (0)
      RG_DMA(0, 0);
      for (int cr = 0; cr < RUN; ++cr) {
        const int ck = run * RUN + cr; const size_t t0 = (size_t)b * SEQ + (size_t)ck * RG_CK;
        LAS unsigned char* Ut = Ub + (cr & 1) * 5120;
        asm volatile("s_waitcnt vmcnt(0)" ::: "memory");
        if (cr + 1 < RUN) RG_DMA(cr + 1, (cr + 1) & 1);
        if (ck == 0 && lane < 24) *(LAS u32x4*)(Ut + lane * 16) = (u32x4){0u, 0u, 0u, 0u};
        if (FINAL) {
#pragma unroll
            for (int p = 0; p < 4; ++p) { const int row = p * 8 + (lane >> 3); *(LAS u32x4*)(Gt + row * 144 + (lane & 7) * 16) = *(const u32x4*)(GT + (t0 + row) * 512 + ch8); } }
        { float cw[4][8], cb[8];
#pragma unroll
            for (int j = 0; j < 4; ++j) { const f32x4 a = *(const f32x4*)(in[5] + j * 512 + ch8), b2 = *(const f32x4*)(in[5] + j * 512 + ch8 + 4); cw[j][0] = a.x; cw[j][1] = a.y; cw[j][2] = a.z; cw[j][3] = a.w; cw[j][4] = b2.x; cw[j][5] = b2.y; cw[j][6] = b2.z; cw[j][7] = b2.w; }
            { const f32x4 a = *(const f32x4*)(in[6] + ch8), b2 = *(const f32x4*)(in[6] + ch8 + 4); cb[0] = a.x; cb[1] = a.y; cb[2] = a.z; cb[3] = a.w; cb[4] = b2.x; cb[5] = b2.y; cb[6] = b2.z; cb[7] = b2.w; }
#pragma unroll
            for (int p = 0; p < 4; ++p) { const int row = p * 8 + (lane >> 3); float o[8];
#pragma unroll
                for (int c = 0; c < 8; ++c) o[c] = cb[c];
#pragma unroll
                for (int j = 0; j < 4; ++j) { const u32x4 x = *(const LAS u32x4*)(Ut + (row + j) * 128 + (lane & 7) * 16);
                    o[0] += cw[j][0] * bf2f(x.x & 0xffffu); o[1] += cw[j][1] * bf2f(x.x >> 16); o[2] += cw[j][2] * bf2f(x.y & 0xffffu); o[3] += cw[j][3] * bf2f(x.y >> 16);
                    o[4] += cw[j][4] * bf2f(x.z & 0xffffu); o[5] += cw[j][5] * bf2f(x.z >> 16); o[6] += cw[j][6] * bf2f(x.w & 0xffffu); o[7] += cw[j][7] * bf2f(x.w >> 16); }
                u32x4 pw; pw.x = pk2(o[0], o[1]); pw.y = pk2(o[2], o[3]); pw.z = pk2(o[4], o[5]); pw.w = pk2(o[6], o[7]);
                *(LAS u32x4*)(UC + row * 144 + (lane & 7) * 16) = pw; } }
        f32x16 ar[2], ai[2];
#pragma unroll
        for (int nb = 0; nb < 2; ++nb)
            { float c0 = cbr[nb], c1 = cbi[nb]; asm volatile("" : "+v"(c0), "+v"(c1));
#pragma unroll
            for (int r = 0; r < 16; ++r) { ar[nb][r] = c0; ai[nb][r] = c1; } }
#pragma unroll
        for (int s = 0; s < 4; ++s) { const bf16x8 a = *(const LAS bf16x8*)(UC + r32 * 144 + (16 * s + 8 * hh) * 2);
#pragma unroll
            for (int nb = 0; nb < 2; ++nb) { ar[nb] = __builtin_amdgcn_mfma_f32_32x32x16_bf16(a, Br[s][nb], ar[nb], 0, 0, 0); ai[nb] = __builtin_amdgcn_mfma_f32_32x32x16_bf16(a, Bi[s][nb], ai[nb], 0, 0, 0); } }
#pragma unroll
        for (int nb = 0; nb < 2; ++nb)
#pragma unroll
            for (int r = 0; r < 16; ++r) {
                const float ucv = bf2f((unsigned)*(const LAS unsigned short*)(UC + hh * 576 + r32 * 2 + CROW0(r) * 144 + 64 * nb));
                const float rg = fast_rcp(1.f + fast_exp2(ar[nb][r])), ig = fast_rcp(1.f + fast_exp2(ai[nb][r]));
                const float a = fast_exp2(csp[nb] * rg); const float g2 = __builtin_amdgcn_sqrtf(__builtin_fmaf(-a, a, 1.f));
                ar[nb][r] = a; ai[nb][r] = g2 * ig * ucv; }
#pragma unroll
        for (int nb = 0; nb < 2; ++nb) {
            float SA[4], SB[4], PA[4], PB[4], inown[4];
#pragma unroll
            for (int k = 0; k < 4; ++k) { const float a0 = ar[nb][4 * k], a1 = ar[nb][4 * k + 1], a2 = ar[nb][4 * k + 2], a3 = ar[nb][4 * k + 3];
                SA[k] = (a0 * a1) * (a2 * a3); SB[k] = ((ai[nb][4 * k] * a1 + ai[nb][4 * k + 1]) * a2 + ai[nb][4 * k + 2]) * a3 + ai[nb][4 * k + 3];
                const u32x2 xa = __builtin_amdgcn_permlane32_swap(__float_as_uint(SA[k]), __float_as_uint(SA[k]), false, false), xb = __builtin_amdgcn_permlane32_swap(__float_as_uint(SB[k]), __float_as_uint(SB[k]), false, false);
                SA[k] = __uint_as_float(xa[0]); PA[k] = __uint_as_float(xa[1]); SB[k] = __uint_as_float(xb[0]); PB[k] = __uint_as_float(xb[1]); }
            float st = h0[nb], atot = 1.f;
#pragma unroll
            for (int k = 0; k < 4; ++k) { const float A0 = SA[k], B0 = SB[k], A1 = PA[k], B1 = PB[k];
                const float in0 = st; st = A0 * st + B0; const float in1 = st; st = A1 * st + B1; inown[k] = hh ? in1 : in0; atot *= A0 * A1; }
            if (!FINAL) { arun[nb] *= atot; h0[nb] = st; }
            else { h0[nb] = st;
#pragma unroll
                for (int k = 0; k < 4; ++k) { float h = inown[k];
#pragma unroll
                    for (int j = 0; j < 4; ++j) { h = ar[nb][4 * k + j] * h + ai[nb][4 * k + j]; ai[nb][4 * k + j] = h; } }
            }
        }
        if (FINAL) {
            float ss[16];
#pragma unroll
            for (int r = 0; r < 16; ++r) { float s = 0.f;
#pragma unroll
                for (int nb = 0; nb < 2; ++nb) { const float gv = bf2f((unsigned)*(const LAS unsigned short*)(Gt + hh * 576 + r32 * 2 + CROW0(r) * 144 + 64 * nb)); const float y = gelu_tanh(gv) * ai[nb][r]; ai[nb][r] = y; s += y * y; }
                ss[r] = half_sum_dpp(s); }
            { float* sq = (float*)(C.ws + WS_SSQRG) + (t0 + 4 * hh) * 8 + w;
#pragma unroll
              for (int r = 0; r < 16; ++r) if (r32 == 31) sq[CROW0(r) * 8] = ss[r]; }
#pragma unroll
            for (int r = 0; r < 16; ++r)
#pragma unroll
                for (int nb = 0; nb < 2; ++nb) *(LAS unsigned short*)(Gt + hh * 576 + r32 * 2 + CROW0(r) * 144 + 64 * nb) = (unsigned short)pk2(ai[nb][r], ai[nb][r]);
#pragma unroll
            for (int p = 0; p < 4; ++p) { const int row = p * 8 + (lane >> 3); const u32x4 yv = *(const LAS u32x4*)(Gt + row * 144 + (lane & 7) * 16);
                if (WOUT_FP8) { u32x2 y8; y8.x = pk4_fp8(bf2f(yv.x & 0xffffu) * F8_MIX_SCALE, bf2f(yv.x >> 16) * F8_MIX_SCALE, bf2f(yv.y & 0xffffu) * F8_MIX_SCALE, bf2f(yv.y >> 16) * F8_MIX_SCALE);
                    y8.y = pk4_fp8(bf2f(yv.z & 0xffffu) * F8_MIX_SCALE, bf2f(yv.z >> 16) * F8_MIX_SCALE, bf2f(yv.w & 0xffffu) * F8_MIX_SCALE, bf2f(yv.w >> 16) * F8_MIX_SCALE);
                    *(u32x2*)((unsigned char*)mixed + (t0 + row) * 1024 + ch8) = y8; }
                else *(u32x4*)(mixed + (t0 + row) * 1024 + ch8) = yv; }
        }
      }
#undef RG_DMA
      if (!FINAL) { if (hh == 0) {
#pragma unroll
          for (int nb = 0; nb < 2; ++nb) *(float2*)(rgsum + (((size_t)(b * NRUN + run)) * 512 + ch0 + 32 * nb + r32) * 2) = make_float2(arun[nb], h0[nb]); } }
    }
}

__device__ __forceinline__ void phase_cmp2(const Ctx& C) {
    int lane_ = C.lane; asm volatile("" : "+v"(lane_));
    const int lane = lane_, r32 = lane & 31, hh = lane >> 5; const intab_t in = C.in;
    const bf16* hid = (const bf16*)(C.ws + WS_CMPHID);
    const int gw = C.bid * 8 + C.wave, NGW = C.G * 8;
    for (int task = gw; task < 512; task += NGW) {
        const int set = task >> 7, blk = task & 127, kv = set >> 1, g = set & 1; const float* w2 = in[kv ? 21 : 19];
        const bf16* arow = hid + ((size_t)set * 4096 + blk * 32 + r32) * 256;
        f32x16 acc[2] = {f32x16{}, f32x16{}};
#pragma unroll 4
        for (int s = 0; s < 16; ++s) { const bf16x8 a = *(const bf16x8*)(arow + 16 * s + 8 * hh);
#pragma unroll
            for (int nb = 0; nb < 2; ++nb) { float bv[8];
#pragma unroll
                for (int j = 0; j < 8; ++j) bv[j] = w2[(16 * s + 8 * hh + j) * 64 + 32 * nb + r32];
                u32x4 pb; pb.x = pk2(bv[0], bv[1]); pb.y = pk2(bv[2], bv[3]); pb.z = pk2(bv[4], bv[5]); pb.w = pk2(bv[6], bv[7]);
                acc[nb] = __builtin_amdgcn_mfma_f32_32x32x16_bf16(a, __builtin_bit_cast(bf16x8, pb), acc[nb], 0, 0, 0); } }
        bf16* dst = (bf16*)(C.ws + (kv ? WS_VCMP : WS_KCMP));
        const float g0 = kv ? 1.f : in[13][r32], g1 = kv ? 1.f : in[13][32 + r32];
#pragma unroll
        for (int r = 0; r < 16; ++r) { const int mrow = blk * 32 + 4 * hh + CROW0(r); const int bb = mrow >> 7, c = mrow & 127;
            float v0 = acc[0][r], v1 = acc[1][r];
            if (!kv) { float s = v0 * v0 + v1 * v1; s += __shfl_xor(s, 1); s += __shfl_xor(s, 2); s += __shfl_xor(s, 4); s += __shfl_xor(s, 8); s += __shfl_xor(s, 16);
                const float rs = __builtin_amdgcn_rsqf(s * (1.f / 64.f) + EPS); v0 *= rs * g0; v1 *= rs * g1; }
            if (c == 127) { v0 = 0.f; v1 = 0.f; }
            bf16* o = dst + (((size_t)bb * 128 + c) * 2 + g) * 64;
            o[r32] = (bf16)f2bf(v0); o[32 + r32] = (bf16)f2bf(v1); }
    }
}
typedef short v4i16_t __attribute__((ext_vector_type(4)));
__device__ __forceinline__ s16x4 trread(const LAS unsigned char* p) { return __builtin_bit_cast(s16x4, __builtin_amdgcn_ds_read_tr16_b64_v4i16((LAS v4i16_t*)p)); }
__device__ __forceinline__ bf16x8 cat8(s16x4 a, s16x4 b) { return (bf16x8){a[0], a[1], a[2], a[3], b[0], b[1], b[2], b[3]}; }
__device__ __forceinline__ bf16x8 packp(const f32x16& p, int s2) { u32x4 w; w.x = pk2(p[8 * s2], p[8 * s2 + 1]); w.y = pk2(p[8 * s2 + 2], p[8 * s2 + 3]); w.z = pk2(p[8 * s2 + 4], p[8 * s2 + 5]); w.w = pk2(p[8 * s2 + 6], p[8 * s2 + 7]); return __builtin_bit_cast(bf16x8, w); }
constexpr int NSA_RK = 0, NSA_RV = 24576;
constexpr int NSA_CK = 0, NSA_CV = 16384, NSA_BIAS = 49152, NSA_WSF = 51264, NSA_IMP = 53312, NSA_YS = 87104, NSA_YSTRIDE = 68, NSA_LSUM = 156736;
#define PIN16(b) asm volatile("" : "+v"(b[0]), "+v"(b[1]), "+v"(b[2]), "+v"(b[3]), "+v"(b[4]), "+v"(b[5]), "+v"(b[6]), "+v"(b[7]), "+v"(b[8]), "+v"(b[9]), "+v"(b[10]), "+v"(b[11]), "+v"(b[12]), "+v"(b[13]), "+v"(b[14]), "+v"(b[15]))
__device__ __forceinline__ void y_accum(LAS float* ys, const f32x16 (&o)[2], float f, LAS float* wsf, int r32, int hh, bool accumulate) {
    if (hh == 0) wsf[r32] = f;
    asm volatile("s_waitcnt lgkmcnt(0)" ::: "memory");
    LAS float* yb = ys + 4 * hh * NSA_YSTRIDE + r32;
#pragma unroll
    for (int r = 0; r < 16; ++r) { const float fr = (wsf + 4 * hh)[CROW0(r)];
        if (accumulate) { yb[CROW0(r) * NSA_YSTRIDE] += o[0][r] * fr; yb[CROW0(r) * NSA_YSTRIDE + 32] += o[1][r] * fr; } else { yb[CROW0(r) * NSA_YSTRIDE] = o[0][r] * fr; yb[CROW0(r) * NSA_YSTRIDE + 32] = o[1][r] * fr; } }
    asm volatile("s_waitcnt lgkmcnt(0)" ::: "memory");
}
typedef int v8i32a __attribute__((ext_vector_type(8)));
typedef int v4i32a __attribute__((ext_vector_type(4)));
__device__ __forceinline__ void nsa_tile(const LAS unsigned char* Kt, const LAS unsigned char* Vt, const v8i32a qf8, f32x16 (&o)[2], float& l,
                                         const LAS float* biasp, int jrel, int qq, bool selbit, bool edge, int kbase, int hh, int vbase) {
    f32x16 p[2];
    const bool far = (jrel >= 3) && !edge;
#define NSA_KF(BLK) __builtin_shufflevector(*(const LAS v4i32a*)(Kt + kbase + (BLK) * 512), *(const LAS v4i32a*)(Kt + kbase + 1024 + (BLK) * 512), 0, 1, 2, 3, 4, 5, 6, 7)
    const float cinit = (far && !selbit) ? -1e30f : 0.f;
#pragma unroll
    for (int r = 0; r < 16; ++r) { p[0][r] = cinit; p[1][r] = cinit; }
    p[0] = __builtin_amdgcn_mfma_scale_f32_32x32x64_f8f6f4(NSA_KF(0), qf8, p[0], 0, 0, 0, 0x7f7f7f7f, 0, 0x7f7f7f7f);
    p[1] = __builtin_amdgcn_mfma_scale_f32_32x32x64_f8f6f4(NSA_KF(1), qf8, p[1], 0, 0, 0, 0x7f7f7f7f, 0, 0x7f7f7f7f);
    float ls = 0.f;
    const int dbase = 64 * jrel + qq - 4 * hh;
#pragma unroll
    for (int blk = 0; blk < 2; ++blk) {
        if (far) {
#pragma unroll
            for (int r = 0; r < 16; ++r) p[blk][r] = fast_exp2(p[blk][r]);
        } else if (!edge) { float bb[16];
#pragma unroll
            for (int r = 0; r < 16; ++r) bb[r] = biasp[min(max(dbase - CROW0(r) - 32 * blk, 0), 128)];
            PIN16(bb);
#pragma unroll
            for (int r = 0; r < 16; ++r) { const int d = dbase - CROW0(r) - 32 * blk; const float e = fast_exp2(p[blk][r] + bb[r]); p[blk][r] = (selbit && d >= 0) ? e : 0.f; }
        } else {
#pragma unroll
            for (int r = 0; r < 16; ++r) { const int d = dbase - CROW0(r) - 32 * blk; const float e = fast_exp2(p[blk][r]); p[blk][r] = (d < 512) ? e : 0.f; }
        }
#pragma unroll
        for (int r = 0; r < 16; ++r) ls += p[blk][r];
#pragma unroll
        for (int s2 = 0; s2 < 2; ++s2) { const bf16x8 pf = packp(p[blk], s2);
#pragma unroll
            for (int db = 0; db < 2; ++db) { const LAS unsigned char* vp = Vt + vbase + db * 4096 + (2 * blk + s2) * 1024;
                o[db] = __builtin_amdgcn_mfma_f32_32x32x16_bf16(pf, cat8(trread(vp), trread(vp + 512)), o[db], 0, 0, 0); } }
    }
    l += ls;
#undef NSA_KF
}

__device__ __forceinline__ void nsa_unit(const Ctx& C, int b, int g, int i) {
    int tid = C.tid; asm volatile("" : "+v"(tid));
    const int w = C.wave, lane = tid & 63, r32 = lane & 31, hh = lane >> 5, p = w >> 1, half = w & 1, h = 4 * g + p;
    const int qq = 32 * half + r32, tq = 64 * i + qq;
    LAS unsigned char* lds = C.lds; LAS float* BIAS = (LAS float*)(lds + NSA_BIAS); LAS float* wsf = (LAS float*)(lds + NSA_WSF) + w * 64; LAS float* IMP = (LAS float*)(lds + NSA_IMP); LAS float* LSUM = (LAS float*)(lds + NSA_LSUM);
    const int vbase = ((lane >> 4) & 1) * 32 + (lane & 3) * 8 + (4 * hh + ((lane & 15) >> 2)) * 64;
    const int kbase = hh * 1024 + r32 * 16;
    const int kbase8 = hh * 2048 + r32 * 16;
    const bf16* kv6 = (const bf16*)(C.ws + WS_KV6);
    __syncthreads();
    { const float* b2 = (const float*)(C.ws + WS_BIAS2); for (int idx = tid; idx < 4 * 132; idx += 512) { const int hp = 4 * g + idx / 132; BIAS[idx] = b2[hp * 132 + idx % 132] - b2[hp * 132 + 128]; } }
    { const char* kcu = (const char*)((const bf16*)(C.ws + WS_KCMP) + ((size_t)b * 256 + g) * 64); const char* vcu = (const char*)((const bf16*)(C.ws + WS_VCMP) + ((size_t)b * 256 + g) * 64);
#pragma unroll 1
        for (int pc = 0; pc < 2; ++pc) { const int piece = tid + 512 * pc, row = piece >> 3, ch = piece & 7; const unsigned off = (unsigned)(row * 128 + ch * 8) * 2u; const int tl = row >> 6, rr = row & 63;
            *(LAS u32x4*)(lds + NSA_CK + tl * 8192 + ch * 1024 + rr * 16) = *(const u32x4*)(kcu + off);
            *(LAS u32x4*)(lds + NSA_CV + tl * 8192 + ((ch >> 2) * 4 + (rr >> 4)) * 1024 + (rr & 15) * 64 + (ch & 3) * 16) = *(const u32x4*)(vcu + off); } }
    const size_t tw = (size_t)b * SEQ + 64 * i + 32 * half;
    const float* gpu = (const float*)(C.ws + WS_GATES) + tw * 24 + h * 3; const unsigned gpo = (unsigned)r32 * 24u;
    __syncthreads();
    bf16x8 qf[4];
    { const char* qpu = (const char*)((const bf16*)(C.ws + WS_Q) + tw * 512 + h * 64); const unsigned qo = (unsigned)(r32 * 512 + 8 * hh) * 2u;
#pragma unroll
        for (int s = 0; s < 4; ++s) qf[s] = *(const bf16x8*)(qpu + qo + 32 * s); }
    const LAS float* biasp = BIAS + p * 132;
    LAS float* ys = (LAS float*)(lds + NSA_YS) + w * (32 * NSA_YSTRIDE);
    {
        const int nkb = (4 * i + 3 + 31) >> 5;
        float ls = 0.f, xprev = 0.f; f32x16 oc[2] = {f32x16{}, f32x16{}};
#pragma unroll 1
        for (int kb = 0; kb < nkb; ++kb) {
            f32x16 s0 = f32x16{}; float bb[16];
#pragma unroll
            for (int s = 0; s < 4; ++s) { const LAS unsigned char* kp = lds + NSA_CK + (kb >> 1) * 8192 + kbase + s * 2048 + (kb & 1) * 512;
                s0 = __builtin_amdgcn_mfma_f32_32x32x16_bf16(*(const LAS bf16x8*)kp, qf[s], s0, 0, 0, 0); }
#pragma unroll
            for (int r = 0; r < 16; ++r) { const int c0 = (32 * kb + 4 * hh) + CROW0(r); bb[r] = biasp[min(max(tq - (16 * c0 + 16), 0), 128)]; }
            PIN16(bb);
#pragma unroll
            for (int r = 0; r < 16; ++r) { const int c0 = (32 * kb + 4 * hh) + CROW0(r);
                const float e = fast_exp2(s0[r] + bb[r]); s0[r] = (16 * c0 + 31 <= tq) ? e : 0.f; ls += s0[r]; }
#pragma unroll
            for (int k = 0; k < 4; ++k) { const float a = (s0[4 * k] + s0[4 * k + 1]) + (s0[4 * k + 2] + s0[4 * k + 3]); const float x = __shfl_xor(s0[4 * k + 3], 32);
                IMP[(p * 64 + qq) * 33 + 8 * kb + 2 * k + hh] = a + (hh ? x : xprev); xprev = x; }
#pragma unroll
            for (int s2 = 0; s2 < 2; ++s2) { const bf16x8 pf = packp(s0, s2);
#pragma unroll
                for (int db = 0; db < 2; ++db) { const LAS unsigned char* vp = lds + NSA_CV + (kb >> 1) * 8192 + vbase + db * 4096 + (2 * (kb & 1) + s2) * 1024;
                    oc[db] = __builtin_amdgcn_mfma_f32_32x32x16_bf16(pf, cat8(trread(vp), trread(vp + 512)), oc[db], 0, 0, 0); } }
        }
        ls += __shfl_xor(ls, 32);
        const float inv = ls > 0.f ? fast_rcp(ls) : 0.f;
        if (hh == 0) LSUM[p * 64 + qq] = inv;
        y_accum(ys, oc, gpu[gpo] * inv, wsf, r32, hh, false);
    }
    __syncthreads();
    int slot = 0;
    const unsigned lds0 = (unsigned)(unsigned long)lds;
#define NSA_SLOTK(s) ((s) < 3 ? NSA_RK + (s) * 8192 : NSA_IMP + ((s) - 3) * 16384)
#define NSA_SLOTV(s) ((s) < 3 ? NSA_RV + (s) * 8192 : NSA_IMP + ((s) - 3) * 16384 + 8192)
#define NSA_DMA(KG, VG, j) do { const int _s = slot; slot = (slot == 4) ? 0 : slot + 1; \
        if (w < 4) glds16((KG) + (size_t)(j) * 8192 + (unsigned)(lane * 128 + w * 16), (unsigned)__builtin_amdgcn_readfirstlane(lds0 + NSA_SLOTK(_s) + w * 1024)); \
        glds16((VG) + (size_t)(j) * 16384 + (unsigned)((16 * (w & 3) + (lane >> 2)) * 256 + (w >> 2) * 64 + (lane & 3) * 16), (unsigned)__builtin_amdgcn_readfirstlane(lds0 + NSA_SLOTV(_s) + w * 1024)); } while (0)
#ifndef NSA_EARLY
#define NSA_EARLY 1
#endif
    if (NSA_EARLY) {
        const char* Kg1 = (const char*)(kv6 + (size_t)2 * ((size_t)T * 128)) + ((size_t)b * SEQ) * 128 + g * 64; const char* Vg1 = (const char*)(kv6 + (size_t)3 * ((size_t)T * 128) + ((size_t)b * SEQ) * 128 + g * 64);
#pragma unroll
        for (int pj = 0; pj < 3; ++pj) if (pj <= i) NSA_DMA(Kg1, Vg1, pj); }
    unsigned selmask;
    if (i <= 7) selmask = (2u << i) - 1u;
    else {
        const float il0 = LSUM[qq], il1 = LSUM[64 + qq], il2 = LSUM[128 + qq], il3 = LSUM[192 + qq];
        unsigned key[29];
#pragma unroll
        for (int n = 1; n <= 29; ++n) { const LAS float* ip = IMP + qq * 33 + n; const float sv = (ip[0] * il0 + ip[64 * 33] * il1) + (ip[2 * 64 * 33] * il2 + ip[3 * 64 * 33] * il3);
            key[n - 1] = (n <= i - 2) ? ((__float_as_uint(sv) & ~31u) | (unsigned)(31 - n)) : 0u; }
        selmask = 1u | (1u << (i - 1)) | (1u << i);
#pragma unroll
        for (int round = 0; round < 5; ++round) { unsigned best = key[28];
#pragma unroll
            for (int n = 0; n < 28; n += 2) best = max(max(key[n], key[n + 1]), best);
            selmask |= best ? (1u << (31u - (best & 31u))) : 0u;
#pragma unroll
            for (int n = 0; n < 29; ++n) key[n] = (key[n] == best) ? 0u : key[n]; }
    }
    v8i32a qf8;
    { const char* qpu = (const char*)((const bf16*)(C.ws + WS_Q) + tw * 512 + h * 64); const unsigned qo = (unsigned)(r32 * 512 + 32 * hh) * 2u;
#pragma unroll
        for (int s = 0; s < 4; ++s) { const bf16x8 v = *(const bf16x8*)(qpu + qo + 16 * s);
            qf8[2 * s] = (int)pk4_fp8(bf2f((unsigned)(unsigned short)v[0]), bf2f((unsigned)(unsigned short)v[1]), bf2f((unsigned)(unsigned short)v[2]), bf2f((unsigned)(unsigned short)v[3]));
            qf8[2 * s + 1] = (int)pk4_fp8(bf2f((unsigned)(unsigned short)v[4]), bf2f((unsigned)(unsigned short)v[5]), bf2f((unsigned)(unsigned short)v[6]), bf2f((unsigned)(unsigned short)v[7])); } }
    __syncthreads();
#ifndef NSA_STREAM_REP
#define NSA_STREAM_REP 1
#endif
#ifndef NSA_VAR
#define NSA_VAR 0
#endif
#pragma unroll 1
    for (int brr = 0; brr < 2 * NSA_STREAM_REP; ++brr) { const int br = 1 + (brr & 1);
        const char* Kgu = (const char*)(kv6 + (size_t)(2 * br) * ((size_t)T * 128)) + ((size_t)b * SEQ) * 128 + g * 64;
        const char* Vgu = (const char*)(kv6 + (size_t)(2 * br + 1) * ((size_t)T * 128) + ((size_t)b * SEQ) * 128 + g * 64);
        const int j0 = (br == 1) ? 0 : (i > 8 ? i - 8 : 0), j1 = i;
        float l = 0.f; f32x16 o[2] = {f32x16{}, f32x16{}};
        int rs_ = (NSA_EARLY && brr == 0) ? 0 : slot;
#pragma unroll
        for (int pj = 0; pj < 4; ++pj) if (j0 + pj <= j1 && !(NSA_EARLY && brr == 0 && pj < 3)) NSA_DMA(Kgu, Vgu, j0 + pj);
        for (int j = j0; j <= j1; ++j) {
            const int ahead = j1 - j;
            if (w < 4) { if (ahead >= 3) asm volatile("s_waitcnt vmcnt(6) lgkmcnt(0)\n\ts_barrier" ::: "memory"); else if (ahead == 2) asm volatile("s_waitcnt vmcnt(4) lgkmcnt(0)\n\ts_barrier" ::: "memory");
                else if (ahead == 1) asm volatile("s_waitcnt vmcnt(2) lgkmcnt(0)\n\ts_barrier" ::: "memory"); else asm volatile("s_waitcnt vmcnt(0) lgkmcnt(0)\n\ts_barrier" ::: "memory"); }
            else { if (ahead >= 3) asm volatile("s_waitcnt vmcnt(3) lgkmcnt(0)\n\ts_barrier" ::: "memory"); else if (ahead == 2) asm volatile("s_waitcnt vmcnt(2) lgkmcnt(0)\n\ts_barrier" ::: "memory");
                else if (ahead == 1) asm volatile("s_waitcnt vmcnt(1) lgkmcnt(0)\n\ts_barrier" ::: "memory"); else asm volatile("s_waitcnt vmcnt(0) lgkmcnt(0)\n\ts_barrier" ::: "memory"); }
            if (j + 4 <= j1 && !(NSA_VAR == 8 && brr >= 2)) NSA_DMA(Kgu, Vgu, j + 4);
            const LAS unsigned char* Kt = lds + NSA_SLOTK(rs_); const LAS unsigned char* Vt = lds + NSA_SLOTV(rs_); rs_ = (rs_ == 4) ? 0 : rs_ + 1;
            nsa_tile(Kt, Vt, qf8, o, l, biasp, i - j, qq, (br == 2) || ((selmask >> j) & 1u), (br == 2) && (i - j == 8), kbase8, hh, vbase);
        }
        l += __shfl_xor(l, 32);
        if (brr < 2) y_accum(ys, o, gpu[gpo + br] * fast_rcp(l), wsf, r32, hh, true);
    }
#undef NSA_DMA
#undef NSA_SLOTK
#undef NSA_SLOTV
    { char* mxu = (char*)((bf16*)(C.ws + WS_C) + tw * 1024 + 512 + h * 64);
#pragma unroll 1
        for (int it = 0; it < 4; ++it) { const int row = (lane >> 3) + 8 * it; const LAS float* yr = ys + row * NSA_YSTRIDE + (lane & 7) * 8; const f32x4 a = *(const LAS f32x4*)yr, c = *(const LAS f32x4*)(yr + 4);
            if (WOUT_FP8) { u32x2 p8; p8.x = pk4_fp8(a.x * F8_MIX_SCALE, a.y * F8_MIX_SCALE, a.z * F8_MIX_SCALE, a.w * F8_MIX_SCALE); p8.y = pk4_fp8(c.x * F8_MIX_SCALE, c.y * F8_MIX_SCALE, c.z * F8_MIX_SCALE, c.w * F8_MIX_SCALE);
                *(u32x2*)(C.ws + WS_C + (tw + row) * 1024 + 512 + h * 64 + (lane & 7) * 8) = p8; }
            else { u32x4 pw; pw.x = pk2(a.x, a.y); pw.y = pk2(a.z, a.w); pw.z = pk2(c.x, c.y); pw.w = pk2(c.z, c.w);
            *(u32x4*)(mxu + (size_t)row * 2048 + (lane & 7) * 16) = pw; }
            float sq = ((a.x * a.x + a.y * a.y) + (a.z * a.z + a.w * a.w)) + ((c.x * c.x + c.y * c.y) + (c.z * c.z + c.w * c.w)); sq += __shfl_xor(sq, 1); sq += __shfl_xor(sq, 2); sq += __shfl_xor(sq, 4);
            if ((lane & 7) == 0) ((float*)(C.ws + WS_SSQNSA))[(tw + row) * 8 + h] = sq; } }
}
__device__ __forceinline__ void phase_nsa(const Ctx& C) {
    const int vcu = (C.G % 8 == 0) ? (C.bid % 8) * (C.G / 8) + C.bid / 8 : C.bid;
#pragma unroll 1
    for (int v = vcu; v < 256; v += C.G) { const int bg = v >> 2, s = v & 3;
#pragma unroll 1
        for (int ui = 0; ui < 8; ++ui) { const int i = (ui & 1) ? (8 * (ui >> 1) + 7 - s) : (8 * (ui >> 1) + s); nsa_unit(C, bg >> 1, bg & 1, i); } }
}

constexpr int XA_KS8 = 272, XA_VS = 320, XA_KT = 0, XA_KTB = 64 * XA_KS8, XA_VT = 4 * XA_KTB, XA_VTB = 20480, XA_WSF = XA_VT + 40960, XA_OST = XA_WSF + 2048;
#ifndef XQ_NT
#define XQ_NT 0
#endif
__device__ __forceinline__ void xattn_unit(const Ctx& C, int b, int hd, int qb) {
    const int tid = C.tid, w = C.wave, lane = C.lane, r32 = lane & 31, hh = lane >> 5;
    LAS unsigned char* lds = C.lds; LAS float* wsf = (LAS float*)(lds + XA_WSF) + w * 64;
    const size_t tw = (size_t)b * SEQ + 256 * qb + 32 * w;
    bf16* xq = (bf16*)(C.ws + WS_A); const bf16* kvx = (const bf16*)(C.ws + WS_KVX) + (size_t)b * 256 * 2048 + hd * 256;
    const int srow = tid >> 4, sch = tid & 15;
    u32x4 kr[4][2];
    { const char* kgu = (const char*)(C.ws + WS_XK8) + ((size_t)b * 256) * 1024 + hd * 256; const unsigned ko = (unsigned)(srow * 1024 + sch * 16);
#pragma unroll
        for (int kt = 0; kt < 4; ++kt)
#pragma unroll
            for (int pc = 0; pc < 2; ++pc) kr[kt][pc] = *(const u32x4*)(kgu + ko + (size_t)(64 * kt + 32 * pc) * 1024); }
    v8i32a qf8[4];
    { const char* qpu = (const char*)(xq + tw * 1024 + hd * 256); const unsigned qo = (unsigned)(r32 * 1024 + 32 * hh) * 2u; float ss = 0.f; bf16x8 qv[4][4];
#pragma unroll
        for (int s = 0; s < 4; ++s)
#pragma unroll
            for (int i = 0; i < 4; ++i) { qv[s][i] = XQ_NT ? __builtin_nontemporal_load((const bf16x8*)(qpu + qo + 128 * s + 16 * i)) : *(const bf16x8*)(qpu + qo + 128 * s + 16 * i);
#pragma unroll
                for (int j = 0; j < 8; ++j) { const float x = bf2f((unsigned)(unsigned short)qv[s][i][j]); ss += x * x; } }
        ss += __shfl_xor(ss, 32);
        const float* sq = (const float*)(C.ws + WS_SSQH1) + tw * 16 + r32 * 16; float tot = 0.f;
#pragma unroll
        for (int j = 0; j < 4; ++j) { const f32x4 x = *(const f32x4*)(sq + 4 * j); tot += (x.x + x.y) + (x.z + x.w); }
        const float rs = __builtin_amdgcn_rsqf(tot * (1.f / 1024.f) + EPS);
        const float rn = rs * __builtin_amdgcn_rsqf(rs * rs * ss * (1.f / 256.f) + EPS) * XQSCALE;
#pragma unroll
        for (int s = 0; s < 4; ++s)
#pragma unroll
            for (int i = 0; i < 4; ++i) { const bf16x8 v = qv[s][i];
                qf8[s][2 * i] = (int)pk4_fp8(bf2f((unsigned)(unsigned short)v[0]) * rn, bf2f((unsigned)(unsigned short)v[1]) * rn, bf2f((unsigned)(unsigned short)v[2]) * rn, bf2f((unsigned)(unsigned short)v[3]) * rn);
                qf8[s][2 * i + 1] = (int)pk4_fp8(bf2f((unsigned)(unsigned short)v[4]) * rn, bf2f((unsigned)(unsigned short)v[5]) * rn, bf2f((unsigned)(unsigned short)v[6]) * rn, bf2f((unsigned)(unsigned short)v[7]) * rn); } }
    f32x16 sc[4][2];
    __syncthreads();
#pragma unroll
    for (int kt = 0; kt < 4; ++kt)
#pragma unroll
        for (int pc = 0; pc < 2; ++pc) *(LAS u32x4*)(lds + XA_KT + kt * XA_KTB + (srow + 32 * pc) * XA_KS8 + sch * 16) = kr[kt][pc];
    const int vrow = tid >> 4, vch = tid & 15;
    const char* vgu = (const char*)(kvx + 1024); const unsigned vo = (unsigned)(vrow * 2048 + vch * 8) * 2u;
    u32x4 vr[2][2];
#pragma unroll
    for (int t2 = 0; t2 < 2; ++t2)
#pragma unroll
        for (int pc = 0; pc < 2; ++pc) vr[t2][pc] = *(const u32x4*)(vgu + vo + (size_t)(64 * t2 + 32 * pc) * 4096);
    __syncthreads();
#pragma unroll
    for (int kt = 0; kt < 4; ++kt) {
        sc[kt][0] = f32x16{}; sc[kt][1] = f32x16{};
#pragma unroll
        for (int s = 0; s < 4; ++s) { const LAS unsigned char* kp = lds + XA_KT + kt * XA_KTB + r32 * XA_KS8 + 64 * s + 32 * hh;
            const v8i32a a0 = __builtin_shufflevector(*(const LAS v4i32a*)kp, *(const LAS v4i32a*)(kp + 16), 0, 1, 2, 3, 4, 5, 6, 7);
            const v8i32a a1 = __builtin_shufflevector(*(const LAS v4i32a*)(kp + 32 * XA_KS8), *(const LAS v4i32a*)(kp + 32 * XA_KS8 + 16), 0, 1, 2, 3, 4, 5, 6, 7);
            sc[kt][0] = __builtin_amdgcn_mfma_scale_f32_32x32x64_f8f6f4(a0, qf8[s], sc[kt][0], 0, 0, 0, 0x7f7f7f7f, 0, 0x7f7f7f7f);
            sc[kt][1] = __builtin_amdgcn_mfma_scale_f32_32x32x64_f8f6f4(a1, qf8[s], sc[kt][1], 0, 0, 0, 0x7f7f7f7f, 0, 0x7f7f7f7f); }
    }
    float mx = -INFINITY;
#pragma unroll
    for (int kt = 0; kt < 4; ++kt)
#pragma unroll
        for (int blk = 0; blk < 2; ++blk)
#pragma unroll
            for (int r = 0; r < 16; ++r) mx = fmaxf(mx, sc[kt][blk][r]);
    mx = fmaxf(mx, __shfl_xor(mx, 32));
    float ls = 0.f; bf16x8 pf[4][2][2];
#pragma unroll
    for (int kt = 0; kt < 4; ++kt)
#pragma unroll
        for (int blk = 0; blk < 2; ++blk) {
#pragma unroll
            for (int r = 0; r < 16; ++r) { const float e = fast_exp2(sc[kt][blk][r] - mx); sc[kt][blk][r] = e; ls += e; }
            pf[kt][blk][0] = packp(sc[kt][blk], 0); pf[kt][blk][1] = packp(sc[kt][blk], 1); }
    ls += __shfl_xor(ls, 32);
    if (hh == 0) wsf[r32] = fast_rcp(ls);
    const int vbase = (4 * hh + ((lane & 15) >> 2)) * XA_VS + (16 * ((lane >> 4) & 1) + 4 * (lane & 3)) * 2;
    char* opu = (char*)((bf16*)(C.ws + WS_C) + ((size_t)b * SEQ + 256 * qb + 32 * w) * 1024 + hd * 256);
    const unsigned oo = (unsigned)(4 * hh * 1024 + r32) * 2u;
#pragma unroll
    for (int pc = 0; pc < 2; ++pc) *(LAS u32x4*)(lds + XA_VT + (vrow + 32 * pc) * XA_VS + vch * 16) = vr[0][pc];
#pragma unroll
    for (int pc = 0; pc < 2; ++pc) vr[0][pc] = *(const u32x4*)(vgu + vo + (size_t)(64 * 2 + 32 * pc) * 4096);
    __syncthreads();
#pragma unroll 1
    for (int dh = 0; dh < 2; ++dh) {
        f32x16 o[4];
#pragma unroll
        for (int db = 0; db < 4; ++db) o[db] = f32x16{};
#pragma unroll
        for (int kt = 0; kt < 4; ++kt) {
            const int n = dh * 4 + kt;
            if (n < 7) {
#pragma unroll
                for (int pc = 0; pc < 2; ++pc) *(LAS u32x4*)(lds + XA_VT + ((kt + 1) & 1) * XA_VTB + (vrow + 32 * pc) * XA_VS + vch * 16) = vr[(kt + 1) & 1][pc];
                { const int n3 = (n + 3) & 7; const size_t nof = (size_t)(n3 >> 2) * 256 + (size_t)(64 * (n3 & 3)) * 4096;
#pragma unroll
                  for (int pc = 0; pc < 2; ++pc) vr[(kt + 1) & 1][pc] = *(const u32x4*)(vgu + vo + nof + (size_t)pc * 32 * 4096); } }
#pragma unroll
            for (int db = 0; db < 4; ++db)
#pragma unroll
                for (int blk = 0; blk < 2; ++blk)
#pragma unroll
                    for (int s2 = 0; s2 < 2; ++s2) { const LAS unsigned char* vp = lds + XA_VT + (kt & 1) * XA_VTB + vbase + (32 * blk + 16 * s2) * XA_VS + 64 * db;
                        o[db] = __builtin_amdgcn_mfma_f32_32x32x16_bf16(pf[kt][blk][s2], cat8(trread(vp), trread(vp + 8 * XA_VS)), o[db], 0, 0, 0); }
            __syncthreads();
        }
#pragma unroll
        for (int r = 0; r < 16; ++r) { const float fr = (wsf + 4 * hh)[CROW0(r)] * (XO_FP8 ? F8_XO_SCALE : 1.f);
            if (XO_FP8) { LAS unsigned char* st = lds + XA_OST + w * 4096 + (4 * hh + CROW0(r)) * 128 + r32;
#pragma unroll
                for (int db = 0; db < 4; ++db) { const float x = __builtin_amdgcn_fmed3f(o[db][r] * fr, -448.f, 448.f); st[32 * db] = (unsigned char)(__builtin_amdgcn_cvt_pk_fp8_f32(x, x, 0, false) & 0xffu); }
            } else { bf16* o2 = (bf16*)(opu + (size_t)CROW0(r) * 2048 + oo) + dh * 128;
#pragma unroll
                for (int db = 0; db < 4; ++db) o2[32 * db] = (bf16)f2bf(o[db][r] * fr); } }
        if (XO_FP8) { asm volatile("s_waitcnt lgkmcnt(0)" ::: "memory");
            unsigned char* x8 = C.ws + WS_C + ((size_t)b * SEQ + 256 * qb + 32 * w) * 1024 + hd * 256 + dh * 128;
#pragma unroll
            for (int it = 0; it < 4; ++it) { const int cid = lane + 64 * it, row = cid >> 3, ch = cid & 7; *(u32x4*)(x8 + (size_t)row * 1024 + ch * 16) = *(const LAS u32x4*)(lds + XA_OST + w * 4096 + row * 128 + ch * 16); }
            asm volatile("s_waitcnt lgkmcnt(0)" ::: "memory"); }
    }
}
__device__ __forceinline__ void phase_xattn(const Ctx& C) {
#ifndef XA_REP
#define XA_REP 1
#endif
    const int vcu = (C.G % 8 == 0) ? (C.bid % 8) * (C.G / 8) + C.bid / 8 : C.bid;
    for (int rep = 0; rep < XA_REP; ++rep)
    for (int L = vcu; L < NBATCH * XH * 8; L += C.G) xattn_unit(C, L >> 5, (L >> 3) & 3, L & 7);
}
constexpr int CTL_CNT = 64;
__device__ __forceinline__ void phase_router(const Ctx& C) {
    const int w = C.wave, lane = C.lane, r32 = lane & 31, hh = lane >> 5; const intab_t in = C.in;
    const bf16* h2b = (const bf16*)(C.ws + WS_H2); const bf16* wr = (const bf16*)(C.ws + WS_WR);
    unsigned* ctl = (unsigned*)(C.ws + WS_CTL); float* tokinfo = (float*)(C.ws + WS_TOKINFO);
    LAS unsigned char* WT = C.lds;
    LAS float* LG = (LAS float*)(C.lds + 73728) + w * (32 * 65); LAS int* hist = (LAS int*)(C.lds + 73728 + 8 * 32 * 65 * 4); LAS int* hbase = hist + 64;
    for (int base_task = C.bid * 8; base_task < T / 32; base_task += C.G * 8) {
        const int task = base_task + w; const size_t tok0 = (size_t)task * 32;
        if (C.tid < 64) hist[C.tid] = 0;
        f32x16 acc[2] = {f32x16{}, f32x16{}}; float ss = 0.f;
        const char* apu = (const char*)(h2b + tok0 * 1024); const unsigned apo = (unsigned)(r32 * 1024 + 32 * hh) * 2u;
#pragma unroll 1
        for (int half = 0; half < 2; ++half) {
            __syncthreads();
            { const u32x4* src = (const u32x4*)(wr + half * 36864); u32x4 st[9];
#pragma unroll
              for (int q = 0; q < 9; ++q) st[q] = src[C.tid + 512 * q];
#pragma unroll
              for (int q = 0; q < 9; ++q) *(LAS u32x4*)(WT + (C.tid + 512 * q) * 16) = st[q]; }
            __syncthreads();
#pragma unroll 8
            for (int sl = 0; sl < 32; ++sl) { const bf16x8 a = *(const bf16x8*)(apu + apo + (unsigned)(half * 512 + 64 * (sl >> 2) + 8 * (sl & 3)) * 2u);
#pragma unroll
                for (int j = 0; j < 8; ++j) { const float x = bf2f((unsigned)(unsigned short)a[j]); ss += x * x; }
                const LAS unsigned char* f0 = WT + ((sl * 2 + hh) * 32 + r32) * 16; const LAS unsigned char* f1 = WT + 65536 + ((sl * 2 + hh) * 4 + (r32 & 3)) * 16;
                const bf16x8 bh0 = *(const LAS bf16x8*)f0, bl0 = *(const LAS bf16x8*)(f0 + 32768);
                bf16x8 bh1 = *(const LAS bf16x8*)f1, bl1 = *(const LAS bf16x8*)(f1 + 4096);
                if (r32 >= 4) { bh1 = bf16x8{}; bl1 = bf16x8{}; }
                acc[0] = __builtin_amdgcn_mfma_f32_32x32x16_bf16(a, bh0, acc[0], 0, 0, 0); acc[0] = __builtin_amdgcn_mfma_f32_32x32x16_bf16(a, bl0, acc[0], 0, 0, 0);
                acc[1] = __builtin_amdgcn_mfma_f32_32x32x16_bf16(a, bh1, acc[1], 0, 0, 0); acc[1] = __builtin_amdgcn_mfma_f32_32x32x16_bf16(a, bl1, acc[1], 0, 0, 0); } }
        ss += __shfl_xor(ss, 32);
        const float rs = __builtin_amdgcn_rsqf(ss * (1.f / 1024.f) + EPS);
#pragma unroll
        for (int r = 0; r < 16; ++r) { (LG + 4 * hh * 65 + r32)[CROW0(r) * 65] = acc[0][r]; (LG + 4 * hh * 65 + r32)[CROW0(r) * 65 + 32] = acc[1][r]; }
        asm volatile("s_waitcnt lgkmcnt(0)" ::: "memory");
        int e0 = 0, e1 = 0, lp0 = 0, lp1 = 0; float w0 = 0.f, w1 = 0.f;
        if (hh == 0) {
            const LAS float* lg = LG + r32 * 65;
            float gl[4]; int gsel = 0; float gmax;
#pragma unroll
            for (int j = 0; j < 4; ++j) gl[j] = lg[j] * rs + in[34][j];
            gmax = gl[0];
#pragma unroll
            for (int j = 1; j < 4; ++j) if (gl[j] > gmax) { gmax = gl[j]; gsel = j; }
            float gsum = 0.f;
#pragma unroll
            for (int j = 0; j < 4; ++j) gsum += __expf(gl[j] - gmax);
            const float pg = 1.f / gsum;
            float el[8]; float m1 = -INFINITY, m2 = -INFINITY; int i1 = 0, i2 = 0;
#pragma unroll
            for (int j = 0; j < 8; ++j) el[j] = lg[4 + 8 * gsel + j] * rs + in[36][8 * gsel + j];
#pragma unroll
            for (int j = 0; j < 8; ++j) if (el[j] > m1) { m1 = el[j]; i1 = j; }
#pragma unroll
            for (int j = 0; j < 8; ++j) if (j != i1 && el[j] > m2) { m2 = el[j]; i2 = j; }
            const float x2 = __expf(m2 - m1); const float p1 = 1.f / (1.f + x2), p2 = x2 * p1;
            e0 = 8 * gsel + i1; e1 = 8 * gsel + i2; w0 = pg * p1; w1 = pg * p2;
            lp0 = atomicAdd((int*)&hist[e0], 1); lp1 = atomicAdd((int*)&hist[32 + e1], 1);
        }
        __syncthreads();
        if (C.tid < 64) { const int c = hist[C.tid]; hbase[C.tid] = c ? (int)atomicAdd(ctl + CTL_CNT + C.tid, (unsigned)c) : 0; }
        __syncthreads();
        if (hh == 0) { float* ti = tokinfo + (tok0 + r32) * 8;
            f32x4 a, b2; a.x = __int_as_float(e0); a.y = __int_as_float(e1); a.z = __int_as_float(hbase[e0] + lp0); a.w = __int_as_float(hbase[32 + e1] + lp1); b2.x = w0; b2.y = w1; b2.z = rs; b2.w = 0.f;
            *(f32x4*)ti = a; *(f32x4*)(ti + 4) = b2; }
        __syncthreads();
    }
}
__device__ __forceinline__ void phase_scatter(const Ctx& C) {
    const unsigned* ctl = (const unsigned*)(C.ws + WS_CTL); LAS int* off = (LAS int*)C.lds;
    MoeInfo* mi = (MoeInfo*)(C.ws + WS_MOEINFO);
    if (C.tid < 64) {
        const int l = C.tid; const int c = (int)__hip_atomic_load(ctl + CTL_CNT + l, __ATOMIC_RELAXED, __HIP_MEMORY_SCOPE_AGENT);
        const int ntl = (c + 255) >> 8; int incl = ntl;
#pragma unroll
        for (int d = 1; d < 64; d <<= 1) { const int t = __shfl_up(incl, d); if (l >= d) incl += t; }
        const int excl = incl - ntl; off[l] = excl << 8;
        const int t32 = __shfl(incl, 31), tot = __shfl(incl, 63);
        if (C.bid == 0) { for (int q = 0; q < ntl; ++q) mi->tile_exp[excl + q] = l & 31; if (l == 0) { mi->nt0 = t32; mi->nt1 = tot - t32; } } }
    __syncthreads();
    float* tokinfo = (float*)(C.ws + WS_TOKINFO);
    int* tokmap = (int*)(C.ws + WS_TOKMAP); float* wslot = (float*)(C.ws + WS_WSLOT); float* rsrow = (float*)(C.ws + WS_RSROW); unsigned* aoff = (unsigned*)(C.ws + WS_AOFF);
    for (int idx = C.bid * 512 + C.tid; idx < 2 * T; idx += C.G * 512) { const int tok = idx >> 1, sl = idx & 1;
        const f32x4 a = *(const f32x4*)(tokinfo + (size_t)tok * 8), b2 = *(const f32x4*)(tokinfo + (size_t)tok * 8 + 4);
        const int e0 = __float_as_int(a.x), e1 = __float_as_int(a.y), p0 = __float_as_int(a.z), p1 = __float_as_int(a.w);
        const int row = sl ? off[32 + e1] + p1 : off[e0] + p0;
        tokmap[row] = tok; wslot[row] = sl ? b2.y : b2.x; rsrow[row] = b2.z; aoff[row] = (unsigned)tok * (MOE_FP8 ? 1024u : 2048u);
    }
}

__device__ __forceinline__ void phase_combine(const Ctx& C) {
    const float* tokinfo = (const float*)(C.ws + WS_TOKINFO); const bf16* h2b = (const bf16*)(C.ws + WS_H2); const bf16* Y = (const bf16*)(C.ws + WS_Y);
    const int gw = C.bid * 8 + C.wave, NGW = C.G * 8;
    for (int tok0 = 2 * gw; tok0 < T; tok0 += 2 * NGW) {
        u32x4 hv[2][2], ya[2][2], yb[2][2];
#pragma unroll
        for (int q = 0; q < 2; ++q) { const int tok = tok0 + q; const f32x4 a = *(const f32x4*)(tokinfo + (size_t)tok * 8); const int r0 = __float_as_int(a.z), r1 = __float_as_int(a.w);
#pragma unroll
            for (int j = 0; j < 2; ++j) { hv[q][j] = ((const u32x4*)(h2b + (size_t)tok * 1024))[C.lane + 64 * j]; ya[q][j] = ((const u32x4*)(Y + (size_t)r0 * 1024))[C.lane + 64 * j]; yb[q][j] = ((const u32x4*)(Y + (size_t)r1 * 1024))[C.lane + 64 * j]; } }
#pragma unroll
        for (int q = 0; q < 2; ++q) { f32x4* op = (f32x4*)(C.out + (size_t)(tok0 + q) * 1024);
#pragma unroll
            for (int j = 0; j < 2; ++j) { const u32x4 h = hv[q][j], p = ya[q][j], r = yb[q][j]; f32x4 o0, o1;
                o0.x = bf2f(h.x & 0xffffu) + (bf2f(p.x & 0xffffu) + bf2f(r.x & 0xffffu)); o0.y = bf2f(h.x >> 16) + (bf2f(p.x >> 16) + bf2f(r.x >> 16));
                o0.z = bf2f(h.y & 0xffffu) + (bf2f(p.y & 0xffffu) + bf2f(r.y & 0xffffu)); o0.w = bf2f(h.y >> 16) + (bf2f(p.y >> 16) + bf2f(r.y >> 16));
                o1.x = bf2f(h.z & 0xffffu) + (bf2f(p.z & 0xffffu) + bf2f(r.z & 0xffffu)); o1.y = bf2f(h.z >> 16) + (bf2f(p.z >> 16) + bf2f(r.z >> 16));
                o1.z = bf2f(h.w & 0xffffu) + (bf2f(p.w & 0xffffu) + bf2f(r.w & 0xffffu)); o1.w = bf2f(h.w >> 16) + (bf2f(p.w >> 16) + bf2f(r.w >> 16));
                op[2 * (C.lane + 64 * j)] = o0; op[2 * (C.lane + 64 * j) + 1] = o1; } }
    }
}
#define XB_TMO      128
#define XB_XCNT(j)  (256  + 64 * (j))
#define XB_XSUB(j)  (1280 + 64 * (j))
#define XB_XGEN(j)  (2304 + 64 * (j))
#define XB_TOP      3328
#define XB_TOPGEN   3392
#define XCD_BAR_WORDS 3456
#define XB_SPIN_CAP (1u << 18)
__device__ __forceinline__ unsigned xb_ld(unsigned* p)              { return __hip_atomic_load(p, __ATOMIC_RELAXED, __HIP_MEMORY_SCOPE_AGENT); }
__device__ __forceinline__ unsigned xb_add(unsigned* p, unsigned v) { return __hip_atomic_fetch_add(p, v, __ATOMIC_RELAXED, __HIP_MEMORY_SCOPE_AGENT); }
__device__ __forceinline__ unsigned xb_xcc_id() { return (unsigned)__builtin_amdgcn_s_getreg((3 << 11) | 20) & 0xFu; }
#define XB_SPIN(cond, bar) do { unsigned _sp = 0; while (cond) { __builtin_amdgcn_s_sleep(1); \
    if ((++_sp & 255u) == 0u) { if (xb_ld(&(bar)[XB_TMO])) break; if (_sp > XB_SPIN_CAP) { atomicAdd(&(bar)[XB_TMO], 1u); break; } } } } while (0)
struct XcdBarrier { unsigned* bar; unsigned x; volatile LAS unsigned* st; };
__device__ __forceinline__ XcdBarrier xcd_barrier_post(unsigned* bar, volatile LAS unsigned* st) {
    XcdBarrier b; b.bar = bar; b.x = xb_xcc_id(); b.st = st;
    if (threadIdx.x == 0) (void)xb_add(&bar[XB_XCNT(b.x)], 1u);
    return b;
}
__device__ __forceinline__ void xcd_barrier_complete(unsigned* bar, unsigned x, unsigned& nloc, unsigned& nx) {
    const unsigned G = gridDim.x * gridDim.y * gridDim.z;
    unsigned sum, cnt, mine, sp = 0u;
    for (;;) {
        sum = 0u; cnt = 0u; mine = 0u;
#pragma unroll
        for (unsigned j = 0; j < 16; ++j) { const unsigned c = xb_ld(&bar[XB_XCNT(j)]); sum += c; cnt += (c > 0u) ? 1u : 0u; mine = (j == x) ? c : mine; }
        if (sum == G) break;
        __builtin_amdgcn_s_sleep(1);
        if ((++sp & 255u) == 0u) { if (xb_ld(&bar[XB_TMO])) break; if (sp > XB_SPIN_CAP) { atomicAdd(&bar[XB_TMO], 1u); break; } }
    }
    nloc = mine > 0u ? mine : 1u; nx = cnt > 0u ? cnt : 1u;
}
__device__ __forceinline__ void xcd_barrier(const XcdBarrier& b) {
    asm volatile("s_waitcnt vmcnt(0)" ::: "memory");
    __syncthreads();
    if (threadIdx.x == 0) {
        unsigned* bar = b.bar;
        __builtin_amdgcn_s_waitcnt(0);
        unsigned nloc = b.st[0], nx = b.st[1];
        if (nloc == 0u) { xcd_barrier_complete(bar, b.x, nloc, nx); b.st[0] = nloc; b.st[1] = nx; }
        const unsigned kbar = b.st[2]; b.st[2] = kbar + 1u;
        const unsigned old = xb_add(&bar[XB_XSUB(b.x)], 1u);
        const unsigned gen = old / nloc;
        if (old + 1u == (gen + 1u) * nloc) {
            __builtin_amdgcn_fence(__ATOMIC_RELEASE, "agent");
            asm volatile("s_waitcnt vmcnt(0)" ::: "memory");
            const unsigned og = xb_add(&bar[XB_TOP], 1u);
            if (og + 1u != (kbar + 1u) * nx) XB_SPIN(xb_ld(&bar[XB_TOP]) < (kbar + 1u) * nx, bar);
            __builtin_amdgcn_fence(__ATOMIC_ACQUIRE, "agent");
            asm volatile("s_waitcnt vmcnt(0)" ::: "memory");
        } else {
            XB_SPIN(xb_ld(&bar[XB_TOP]) < (kbar + 1u) * nx, bar);
            __builtin_amdgcn_fence(__ATOMIC_ACQUIRE, "agent");
            asm volatile("s_waitcnt vmcnt(0)" ::: "memory");
        }
    }
    __syncthreads();
}
constexpr int NPHASE = 15;
constexpr int LDS_BYTES = 163840;
template <int PH> __device__ __forceinline__ void run_phase(const Ctx& C0) {
    Ctx C = C0; asm volatile("" : "+v"(C.tid)); C.lane = C.tid & 63;
    unsigned char* ws = C.ws;
    const pg8::Gemm g1024{1024, 1024, 64}, g512{512, 512, 64}, g256{256, 256, 64}, gcmp{2048, 2048, 128};
    if constexpr (PH == 0) phase_prologue(C);
    if constexpr (PH == 1) {
        { SchedDense S; S.init(T, NPROJ_PAD, C.G, C.bid, ws + WS_A, 2048, ws + WS_WIN, 2048);
          EpiInProj E{ws};
          pg8::gemm_phase<EpiInProj, SchedDense>(C.lds, g1024, S, E);
#ifdef PROBE_G1_PLAIN
          { EpiPlain E2{(bf16*)(ws + WS_H1F8), 1024, 1.f}; pg8::gemm_phase<EpiPlain, SchedDense>(C.lds, g1024, S, E2); }
#endif
#ifdef PROBE_G1_FULL
          pg8::gemm_phase<EpiInProj, SchedDense>(C.lds, g1024, S, E);
#endif
          }
        { SchedDense S; S.init(TM, 2048, C.G, C.bid, ws + WS_MNB, XKV_FP8 ? 1024 : 2048, ws + WS_WKV, XKV_FP8 ? 1024 : 2048);
          EpiPlain E{(bf16*)(ws + WS_KVX), 2048, XKV_FP8 ? 1.f / F8_WKV_SCALE : 1.f};
          pg8::gemm_phase<EpiPlain, SchedDense, true, true, XKV_FP8 != 0>(C.lds, XKV_FP8 ? g512 : g1024, S, E); }
    }
    if constexpr (PH == 2) {
        { SchedCmp S{C.G, C.bid, (const char*)(ws + WS_KV6), (const char*)(ws + WS_KV6) + (size_t)T * 256, (const char*)(ws + WS_CW1)};
          EpiCmp1 E{(bf16*)(ws + WS_CMPHID), (const float*)(ws + WS_CB1P)};
          pg8::gemm_phase<EpiCmp1, SchedCmp>(C.lds, gcmp, S, E); }
        __syncthreads();
        pass_knorm(C);
#ifndef P2_SA
#define P2_SA 2
#define P2_SB 1
#define P2_SC 10
#endif
        static_assert(64 * P2_SA + 64 * P2_SB + 64 * (2 * P2_SC + 1) == 1536, "slab split");
        {
            const bool bal = (C.G == 256); const int kind = C.bid < 64 ? 0 : (C.bid < 128 ? 1 : 2);
#ifndef P2_STAGGER
#define P2_STAGGER 1
#endif
            const bool slabs_first = P2_STAGGER && bal && kind == 2 && (((C.bid - 128) >> 3) & 1);
            __syncthreads();
            if (slabs_first) { const int q = C.bid - 128, pr = (q & 7) | ((q >> 4) << 3); const int s0 = 64 * (P2_SA + P2_SB) + pr * (2 * P2_SC + 1), sn = P2_SC;
                phase_expert_weights_wg(C, s0, 1, s0 + sn);
                __syncthreads();
                phase_rg<false>(C, C.bid, -1); }
            else {
                if (!bal || kind) phase_rg<false>(C, bal ? C.bid : -2, (bal && kind == 1) ? C.bid - 64 : -1);
                __syncthreads();
                if (bal) { int s0, sn;
                    if (kind == 0) { s0 = C.bid * P2_SA; sn = P2_SA; }
                    else if (kind == 1) { s0 = 64 * P2_SA + (C.bid - 64) * P2_SB; sn = P2_SB; }
                    else { const int q = C.bid - 128;
                        if (P2_STAGGER) { const int pr = (q & 7) | ((q >> 4) << 3); s0 = 64 * (P2_SA + P2_SB) + pr * (2 * P2_SC + 1) + P2_SC; sn = P2_SC + 1; }
                        else { s0 = 64 * (P2_SA + P2_SB) + (q >> 1) * (2 * P2_SC + 1) + (q & 1) * P2_SC; sn = P2_SC + (q & 1); } }
                    phase_expert_weights_wg(C, s0, 1, s0 + sn); }
                else if (C.G > 64) { if (C.bid >= 64) phase_expert_weights_wg(C, C.bid - 64, C.G - 64); }
                else phase_expert_weights(C, C.bid * 8 + C.wave, C.G * 8); }
        }
    }
    if constexpr (PH == 3) { phase_cmp2(C); phase_rg<true>(C); }
    if constexpr (PH == 4) phase_nsa(C);
    if constexpr (PH == 5) { }
    if constexpr (PH == 6) { SchedDense S; S.init(T, 1024, C.G, C.bid, ws + WS_C, WOUT_FP8 ? 1024 : 2048, ws + WS_WOUT, WOUT_FP8 ? 1024 : 2048);
        EpiOutMid E{(const bf16*)(ws + WS_A), (bf16*)(ws + WS_H1), (float*)(ws + WS_SSQH1), (const float*)(ws + WS_SSQRG), (const float*)(ws + WS_SSQNSA), XQ_FP8 ? ws + WS_H1F8 : nullptr};
        pg8::gemm_phase<EpiOutMid, SchedDense, true, true, WOUT_FP8 != 0>(C.lds, WOUT_FP8 ? g512 : g1024, S, E); }
    if constexpr (PH == 7) { SchedDense S; S.init(T, 1024, C.G, C.bid, XQ_FP8 ? ws + WS_H1F8 : ws + WS_H1, XQ_FP8 ? 1024 : 2048, ws + WS_WQ, XQ_FP8 ? 1024 : 2048);
        EpiPlain E{(bf16*)(ws + WS_A), 1024, XQ_FP8 ? 1.f / F8_WQ_SCALE : 1.f};
        pg8::gemm_phase<EpiPlain, SchedDense, true, true, XQ_FP8 != 0>(C.lds, XQ_FP8 ? g512 : g1024, S, E); }
    if constexpr (PH == 8) phase_xattn(C);
    if constexpr (PH == 9) { SchedDense S; S.init(T, 1024, C.G, C.bid, ws + WS_C, XO_FP8 ? 1024 : 2048, ws + WS_WO, XO_FP8 ? 1024 : 2048);
        EpiRes E{(const bf16*)(ws + WS_H1), (bf16*)(ws + WS_H2), nullptr, MOE_FP8 ? ws + WS_H2F8 : nullptr, XO_FP8 ? 1.f / (F8_WO_SCALE * F8_XO_SCALE) : 1.f};
        pg8::gemm_phase<EpiRes, SchedDense, true, true, XO_FP8 != 0>(C.lds, XO_FP8 ? g512 : g1024, S, E); }
    if constexpr (PH == 10) phase_router(C);
    if constexpr (PH == 11) phase_scatter(C);
    const MoeInfo* mi = (const MoeInfo*)(ws + WS_MOEINFO);
    constexpr size_t EB = MOE_FP8 ? 1 : 2;
    if constexpr (PH == 12) { const int nt0 = mi->nt0, nt1 = mi->nt1;
        SchedMoeT<true> S{C.G, C.bid, 0, nt0 + nt1, mi->tile_exp, (const char*)(ws + (MOE_FP8 ? WS_H2F8 : WS_H2)), (const char*)(ws + WS_W13), 0, (size_t)256 * 1024 * EB, (const unsigned*)(ws + WS_AOFF)};
        EpiMoe1 E{ws + WS_C, (const float*)(ws + WS_WSLOT), (const float*)(ws + WS_RSROW)};
        pg8::gemm_phase<EpiMoe1, SchedMoeT<true>, true, true, MOE_FP8 != 0>(C.lds, MOE_FP8 ? g512 : g1024, S, E); }
    if constexpr (PH == 13) { const int nt0 = mi->nt0;
        SchedMoeT<false> S{C.G, C.bid, 0, nt0, mi->tile_exp, (const char*)(ws + WS_C), (const char*)(ws + WS_W2), (size_t)256 * 512 * EB, (size_t)256 * 512 * EB, nullptr};
        EpiMoe2<0> E{(const int*)(ws + WS_TOKMAP), (const bf16*)(ws + WS_H2), (bf16*)(ws + WS_A), C.out};
        pg8::gemm_phase<EpiMoe2<0>, SchedMoeT<false>, true, true, MOE_FP8 != 0>(C.lds, MOE_FP8 ? g256 : g512, S, E); }
    if constexpr (PH == 14) { const int nt0 = mi->nt0, nt1 = mi->nt1;
        SchedMoeT<false> S{C.G, C.bid, nt0, nt1, mi->tile_exp, (const char*)(ws + WS_C), (const char*)(ws + WS_W2), (size_t)256 * 512 * EB, (size_t)256 * 512 * EB, nullptr};
        EpiMoe2<1> E{(const int*)(ws + WS_TOKMAP), (const bf16*)(ws + WS_A), (bf16*)(ws + WS_A), C.out};
        pg8::gemm_phase<EpiMoe2<1>, SchedMoeT<false>, true, true, MOE_FP8 != 0>(C.lds, MOE_FP8 ? g256 : g512, S, E); }
}
#ifndef DUP_PHASE
#define DUP_PHASE -1
#endif
__global__ void __launch_bounds__(512, 2) hymba_fwd(Args args) {
    extern __shared__ __attribute__((aligned(16))) unsigned char lds_raw[];
    const __attribute__((address_space(4))) unsigned char* ka = (const __attribute__((address_space(4))) unsigned char*)__builtin_amdgcn_kernarg_segment_ptr(); asm volatile("" : "+s"(ka));
    Ctx C; C.in = (intab_t)ka; C.out = args.out; C.ws = args.ws; C.lds = (LAS unsigned char*)lds_raw; C.tid = threadIdx.x; C.lane = C.tid & 63; C.wave = __builtin_amdgcn_readfirstlane(C.tid >> 6); C.G = gridDim.x; C.bid = blockIdx.x;
    const int lo = args.lo, hi = args.hi;
    volatile LAS unsigned* bst = (volatile LAS unsigned*)(C.lds + LDS_BYTES - 64);
    if (C.tid < 3) bst[C.tid] = 0u;
    __syncthreads();
    const XcdBarrier xbar = xcd_barrier_post((unsigned*)(args.ws + WS_CTL + 16384), bst);
#define IN(k) (lo <= (k) && (k) < hi)
#define GBAR(k) xcd_barrier(xbar)
#ifndef PHMASK
#define PHMASK 0x7fff
#endif
#define PHSEL(k) (((PHMASK) >> (k)) & 1)
#define PHASE(k) do { if (PHSEL(k) && IN(k)) { run_phase<k>(C); if (DUP_PHASE == (k)) { xcd_barrier(xbar); run_phase<k>(C); } } if (IN(k) && (k) + 1 < hi) GBAR(k); } while (0)
#ifdef XBAR_EXTRA
    for (int xe = 0; xe < XBAR_EXTRA; ++xe) xcd_barrier(xbar);
#endif
    PHASE(0); PHASE(1); PHASE(2); PHASE(3); PHASE(4); PHASE(6); PHASE(7); PHASE(8); PHASE(9); PHASE(10); PHASE(11); PHASE(12); PHASE(13); PHASE(14);
#undef IN
#undef PHASE
#undef GBAR
}

#ifndef N_LAUNCH_MODE
#define N_LAUNCH_MODE 0
#endif
extern "C" void kernel_launch(void* const* d_in, const int* in_sizes, int n_in, void* d_out, int out_size, void* d_ws, size_t ws_size, hipStream_t stream) {
    static int grid = 0;
    if (grid == 0) {
        if (n_in != 40 || out_size != T * DM || ws_size < WS_END) { fprintf(stderr, "kernel_launch: unexpected problem (n_in %d out %d ws %zu)\n", n_in, out_size, ws_size); grid = -1; return; }
        int dev = 0, cus = 0, per_cu = 0;
        if (hipGetDevice(&dev) != hipSuccess || hipDeviceGetAttribute(&cus, hipDeviceAttributeMultiprocessorCount, dev) != hipSuccess) { grid = -1; return; }
        if (hipFuncSetAttribute((const void*)hymba_fwd, hipFuncAttributeMaxDynamicSharedMemorySize, LDS_BYTES) != hipSuccess) { fprintf(stderr, "kernel_launch: hipFuncSetAttribute failed\n"); grid = -1; return; }
        if (hipOccupancyMaxActiveBlocksPerMultiprocessor(&per_cu, (const void*)hymba_fwd, 512, LDS_BYTES) != hipSuccess || per_cu < 1) { fprintf(stderr, "kernel_launch: occupancy query says %d\n", per_cu); (void)hipGetLastError(); }
        grid = cus;
    }
    if (grid < 0) return;
    (void)hipMemsetAsync((char*)d_ws + WS_CTL, 0, CTL_BYTES, stream);
    Args a{};
    for (int i = 0; i < 40; ++i) a.in[i] = (const float*)d_in[i];
    a.out = (float*)d_out; a.ws = (unsigned char*)d_ws;
#if N_LAUNCH_MODE == 0
    a.lo = 0; a.hi = NPHASE;
    void* kargs[] = {&a};
    hipError_t e = hipLaunchCooperativeKernel((const void*)hymba_fwd, dim3(grid), dim3(512), kargs, LDS_BYTES, stream);
    if (e != hipSuccess) fprintf(stderr, "cooperative launch failed: %s (grid %d)\n", hipGetErrorString(e), grid);
#else
    for (int ph = 0; ph < NPHASE; ++ph) { a.lo = ph; a.hi = ph + 1; hipLaunchKernelGGL(hymba_fwd, dim3(grid), dim3(512), LDS_BYTES, stream, a); }
#endif
}
```
